# Optimizing an MI355X kernel written in HIP

```python
import jax, jax.numpy as jnp
from jax import lax
import numpy as np

D_MODEL = 2048
BATCH = 4
SEQ = 4096
DEPTH = 2

HEAD_DIM = 128
N_HEADS_MOBA = 8
N_HEADS_FOX = 8
N_HEADS_MLA = 8
MOBA_BLOCK = 256
MOBA_TOPK = 3
MOBA_Q_CHUNK = 64
Q_BLOCK = 128
MLA_Q_LORA = 512
MLA_KV_LORA = 512
MLA_NOPE = 128
MLA_ROPE = 64
MLA_V = 128
ROPE_BASE = 10000.0
N_BRANCH = 3
D_FF = 5632
N_EXPERTS = 8
TOP_K = 2
D_FF_EXPERT = 7168
MOE_ROW_BLOCK = 512
LN_EPS = 1e-5
RMS_EPS = 1e-6
DEEPNORM_ALPHA = (2 * DEPTH) ** 0.25
DEEPNORM_BETA = (8 * DEPTH) ** -0.25

W_MOBA = N_HEADS_MOBA * HEAD_DIM
W_FOX = N_HEADS_FOX * HEAD_DIM
MLA_QK = MLA_NOPE + MLA_ROPE
W_MLA_OUT = N_HEADS_MLA * MLA_V
SPLITS = (3 * W_MOBA, 3 * W_FOX, N_HEADS_FOX, MLA_Q_LORA, MLA_KV_LORA, MLA_ROPE, N_BRANCH * D_MODEL)
D_IN_PROJ = sum(SPLITS)

kernel_name = "hybrid_moba_fox_mla_gated_deepnorm_moe"


def layer_norm(x, g, b):
    xf = x.astype(jnp.float32)
    mu = jnp.mean(xf, -1, keepdims=True)
    var = jnp.mean(jnp.square(xf - mu), -1, keepdims=True)
    return ((xf - mu) * lax.rsqrt(var + LN_EPS)).astype(x.dtype) * g + b


def rms_norm(x, g):
    xf = x.astype(jnp.float32)
    return (xf * lax.rsqrt(jnp.mean(xf * xf, -1, keepdims=True) + RMS_EPS)).astype(x.dtype) * g


def rope_tables(positions, dtype):
    inv = ROPE_BASE ** (-jnp.arange(0, MLA_ROPE, 2, dtype=jnp.float32) / MLA_ROPE)
    ang = positions.astype(jnp.float32)[..., None] * inv
    return jnp.cos(ang).astype(dtype), jnp.sin(ang).astype(dtype)


def apply_rope(t, cos, sin):
    t1, t2 = jnp.split(t, 2, axis=-1)
    return jnp.concatenate([t1 * cos - t2 * sin, t2 * cos + t1 * sin], axis=-1)


def alibi_slopes(n):
    return 2.0 ** (-8.0 * jnp.arange(1, n + 1, dtype=jnp.float32) / n)


def moba_attention(q, k, v):
    b, h, s, d = q.shape
    nb = -(-s // MOBA_BLOCK)
    pad = nb * MOBA_BLOCK - s
    kp = jnp.pad(k, ((0, 0), (0, 0), (0, pad), (0, 0)))
    vp = jnp.pad(v, ((0, 0), (0, 0), (0, pad), (0, 0)))
    kb = kp.reshape(b, h, nb, MOBA_BLOCK, d)
    vb = vp.reshape(b, h, nb, MOBA_BLOCK, d)
    scale = d ** -0.5
    slopes = alibi_slopes(h)[None, :, None, None]
    kmean = jnp.mean(kb.astype(jnp.float32), axis=3)
    gate = jnp.einsum('bhsd,bhnd->bhsn', q.astype(jnp.float32), kmean)
    cur = jnp.arange(s) // MOBA_BLOCK
    past = jnp.arange(nb)[None, :] < cur[:, None]
    gate = jnp.where(past, gate, -jnp.inf)
    k_sel = min(MOBA_TOPK, nb)
    _, sel = lax.top_k(gate, k_sel)
    valid = jnp.arange(k_sel)[None, :] < cur[:, None]
    gather_blocks = jax.vmap(jax.vmap(lambda blk, i: blk[i]))

    def chunk(ci):
        q0 = ci * MOBA_Q_CHUNK
        qc = lax.dynamic_slice_in_dim(q, q0, MOBA_Q_CHUNK, axis=2)
        sc = lax.dynamic_slice_in_dim(sel, q0, MOBA_Q_CHUNK, axis=2)
        vc = lax.dynamic_slice_in_dim(valid, q0, MOBA_Q_CHUNK, axis=0)
        qpos = q0 + jnp.arange(MOBA_Q_CHUNK)
        k_g = gather_blocks(kb, sc)
        v_g = gather_blocks(vb, sc)
        kpos_g = sc[..., None] * MOBA_BLOCK + jnp.arange(MOBA_BLOCK)
        s_g = (jnp.einsum('bhcd,bhckjd->bhckj', qc, k_g).astype(jnp.float32) * scale
               - slopes[..., None] * (qpos[:, None, None] - kpos_g).astype(jnp.float32))
        s_g = jnp.where(vc[:, :, None], s_g, -jnp.inf)
        o0 = (q0 // MOBA_BLOCK) * MOBA_BLOCK
        k_o = lax.dynamic_slice_in_dim(kp, o0, MOBA_BLOCK, axis=2)
        v_o = lax.dynamic_slice_in_dim(vp, o0, MOBA_BLOCK, axis=2)
        kpos_o = o0 + jnp.arange(MOBA_BLOCK)
        dist_o = (qpos[:, None] - kpos_o[None, :]).astype(jnp.float32)
        s_o = jnp.einsum('bhcd,bhjd->bhcj', qc, k_o).astype(jnp.float32) * scale - slopes * dist_o
        s_o = jnp.where(dist_o >= 0, s_o, -jnp.inf)
        logits = jnp.concatenate([s_g.reshape(b, h, MOBA_Q_CHUNK, k_sel * MOBA_BLOCK), s_o], axis=-1)
        p = jax.nn.softmax(logits, axis=-1).astype(v.dtype)
        p_g = p[..., :k_sel * MOBA_BLOCK].reshape(b, h, MOBA_Q_CHUNK, k_sel, MOBA_BLOCK)
        p_o = p[..., k_sel * MOBA_BLOCK:]
        return (jnp.einsum('bhckj,bhckjd->bhcd', p_g, v_g)
                + jnp.einsum('bhcj,bhjd->bhcd', p_o, v_o))

    out = lax.map(chunk, jnp.arange(s // MOBA_Q_CHUNK))
    return out.transpose(1, 2, 0, 3, 4).reshape(b, h, s, d)


def blocked_causal_attention(q, k, v, scale, decay_cum=None):
    b, h, s, _ = q.shape
    dv = v.shape[-1]
    kpos = jnp.arange(s)

    def block(qi):
        q0 = qi * Q_BLOCK
        qb = lax.dynamic_slice_in_dim(q, q0, Q_BLOCK, axis=2)
        qpos = q0 + jnp.arange(Q_BLOCK)
        logits = jnp.einsum('bhqd,bhkd->bhqk', qb, k).astype(jnp.float32) * scale
        if decay_cum is not None:
            cq = lax.dynamic_slice_in_dim(decay_cum, q0, Q_BLOCK, axis=2)
            logits = logits + (cq[..., :, None] - decay_cum[..., None, :])
        logits = jnp.where(kpos[None, :] <= qpos[:, None], logits, -jnp.inf)
        p = jax.nn.softmax(logits, axis=-1).astype(v.dtype)
        return jnp.einsum('bhqk,bhkd->bhqd', p, v)

    out = lax.map(block, jnp.arange(s // Q_BLOCK))
    return out.transpose(1, 2, 0, 3, 4).reshape(b, h, s, dv)


def token_mixer(x, cos, sin, w_in, b_forget, g_q_a, g_kv_a, w_q_b, w_kv_b,
                w_branch_moba, w_branch_fox, w_branch_mla, w_o):
    b, s, _ = x.shape
    proj = x @ w_in
    p_moba, p_fox, p_forget, c_q, c_kv, k_rope_raw, p_gate = jnp.split(
        proj, np.cumsum(SPLITS)[:-1].tolist(), axis=-1)

    def heads(t, n):
        return t.reshape(b, s, n, -1).transpose(0, 2, 1, 3)

    def merge(t):
        return t.transpose(0, 2, 1, 3).reshape(b, s, -1)

    qa, ka, va = [heads(t, N_HEADS_MOBA) for t in jnp.split(p_moba, 3, axis=-1)]
    o_moba = merge(moba_attention(qa, ka, va))

    qf, kf, vf = [heads(t, N_HEADS_FOX) for t in jnp.split(p_fox, 3, axis=-1)]
    log_f = jax.nn.log_sigmoid(p_forget.astype(jnp.float32) + b_forget.astype(jnp.float32))
    c = jnp.cumsum(log_f, axis=1).transpose(0, 2, 1)
    o_fox = merge(blocked_causal_attention(qf, kf, vf, HEAD_DIM ** -0.5, decay_cum=c))

    q_m = (rms_norm(c_q, g_q_a) @ w_q_b).reshape(b, s, N_HEADS_MLA, MLA_QK)
    q_nope, q_pe = jnp.split(q_m, [MLA_NOPE], axis=-1)
    q_pe = apply_rope(q_pe, cos[:, :, None, :], sin[:, :, None, :])
    q_m = jnp.concatenate([q_nope, q_pe], axis=-1)
    kv = (rms_norm(c_kv, g_kv_a) @ w_kv_b).reshape(b, s, N_HEADS_MLA, MLA_NOPE + MLA_V)
    k_nope, v_m = jnp.split(kv, [MLA_NOPE], axis=-1)
    k_pe = apply_rope(k_rope_raw, cos, sin)
    k_m = jnp.concatenate(
        [k_nope, jnp.broadcast_to(k_pe[:, :, None, :], (b, s, N_HEADS_MLA, MLA_ROPE))], axis=-1)
    o_mla = merge(blocked_causal_attention(q_m.transpose(0, 2, 1, 3), k_m.transpose(0, 2, 1, 3),
                                           v_m.transpose(0, 2, 1, 3), MLA_QK ** -0.5))

    g_a, g_b, g_c = jnp.split(p_gate, 3, axis=-1)
    merged = (jax.nn.sigmoid(g_a) * (o_moba @ w_branch_moba)
              + jax.nn.sigmoid(g_b) * (o_fox @ w_branch_fox)
              + jax.nn.sigmoid(g_c) * (o_mla @ w_branch_mla))
    return merged @ w_o


def swiglu(x, w1, w3, w2):
    return (jax.nn.silu(x @ w1) * (x @ w3)) @ w2


def moe_swiglu(x, w_router, w1, w3, w2):
    b, s, d = x.shape
    t = b * s
    xt = x.reshape(t, d)
    logits = (xt @ w_router).astype(jnp.float32)
    top_val, top_idx = lax.top_k(logits, TOP_K)
    gates = jax.nn.softmax(top_val, axis=-1)
    flat_e = top_idx.reshape(-1)
    flat_tok = jnp.repeat(jnp.arange(t, dtype=jnp.int32), TOP_K)
    flat_g = gates.reshape(-1)
    order = jnp.argsort(flat_e)
    e_sorted = flat_e[order]
    counts = jnp.zeros((N_EXPERTS,), jnp.int32).at[flat_e].add(1)
    padded = (counts + MOE_ROW_BLOCK - 1) // MOE_ROW_BLOCK * MOE_ROW_BLOCK
    start_sorted = jnp.cumsum(counts) - counts
    end_padded = jnp.cumsum(padded)
    start_padded = end_padded - padded
    rank = jnp.arange(t * TOP_K, dtype=jnp.int32) - start_sorted[e_sorted]
    dest = start_padded[e_sorted] + rank
    n_rows = (-(-(t * TOP_K) // MOE_ROW_BLOCK) + N_EXPERTS) * MOE_ROW_BLOCK
    row_tok = jnp.full((n_rows,), t, jnp.int32).at[dest].set(flat_tok[order])
    row_gate = jnp.zeros((n_rows,), jnp.float32).at[dest].set(flat_g[order])
    n_blk = n_rows // MOE_ROW_BLOCK
    blk_e = jnp.minimum(
        jnp.searchsorted(end_padded, jnp.arange(n_blk, dtype=jnp.int32) * MOE_ROW_BLOCK, side='right'),
        N_EXPERTS - 1)
    x_pad = jnp.concatenate([xt, jnp.zeros((1, d), xt.dtype)], axis=0)
    xb = x_pad[row_tok].reshape(n_blk, MOE_ROW_BLOCK, d)

    def expert_block(args):
        xi, e = args
        return swiglu(xi, w1[e], w3[e], w2[e])

    yb = lax.map(expert_block, (xb, blk_e)).reshape(n_rows, d)
    y = jnp.zeros((t + 1, d), x.dtype).at[row_tok].add(yb * row_gate[:, None].astype(x.dtype))[:t]
    return y.reshape(b, s, d)


def setup_inputs(seed: int = 0) -> dict:
    key = jax.random.key(seed)
    ks = jax.random.split(key, 24)
    f32 = jnp.float32
    n_dense = (DEPTH + 1) // 2
    n_moe = DEPTH // 2

    def nrm(k, shape, fan_in, mult=1.0):
        return jax.random.normal(k, shape, f32) * (mult * fan_in ** -0.5)

    def gain(k, shape):
        return 1.0 + 0.02 * jax.random.normal(k, shape, f32)

    return {
        "x": jax.random.normal(ks[0], (BATCH, SEQ, D_MODEL), f32),
        "positions": jnp.broadcast_to(jnp.arange(SEQ, dtype=jnp.int32), (BATCH, SEQ)),
        "w_in": nrm(ks[1], (DEPTH, D_MODEL, D_IN_PROJ), D_MODEL),
        "b_forget": jax.random.uniform(ks[2], (DEPTH, N_HEADS_FOX), f32, 1.0, 3.0),
        "g_q_a": gain(ks[3], (DEPTH, MLA_Q_LORA)),
        "g_kv_a": gain(ks[4], (DEPTH, MLA_KV_LORA)),
        "w_q_b": nrm(ks[5], (DEPTH, MLA_Q_LORA, N_HEADS_MLA * MLA_QK), MLA_Q_LORA),
        "w_kv_b": nrm(ks[6], (DEPTH, MLA_KV_LORA, N_HEADS_MLA * (MLA_NOPE + MLA_V)), MLA_KV_LORA),
        "w_branch_moba": nrm(ks[7], (DEPTH, W_MOBA, D_MODEL), W_MOBA),
        "w_branch_fox": nrm(ks[8], (DEPTH, W_FOX, D_MODEL), W_FOX),
        "w_branch_mla": nrm(ks[9], (DEPTH, W_MLA_OUT, D_MODEL), W_MLA_OUT),
        "w_o": nrm(ks[10], (DEPTH, D_MODEL, D_MODEL), D_MODEL, DEEPNORM_BETA),
        "ln1_g": gain(ks[11], (DEPTH, D_MODEL)),
        "ln1_b": 0.01 * jax.random.normal(ks[12], (DEPTH, D_MODEL), f32),
        "ln2_g": gain(ks[13], (DEPTH, D_MODEL)),
        "ln2_b": 0.01 * jax.random.normal(ks[14], (DEPTH, D_MODEL), f32),
        "ffn_w1": nrm(ks[15], (n_dense, D_MODEL, D_FF), D_MODEL),
        "ffn_w3": nrm(ks[16], (n_dense, D_MODEL, D_FF), D_MODEL),
        "ffn_w2": nrm(ks[17], (n_dense, D_FF, D_MODEL), D_FF, DEEPNORM_BETA),
        "moe_router": nrm(ks[18], (n_moe, D_MODEL, N_EXPERTS), D_MODEL),
        "moe_w1": nrm(ks[19], (n_moe, N_EXPERTS, D_MODEL, D_FF_EXPERT), D_MODEL),
        "moe_w3": nrm(ks[20], (n_moe, N_EXPERTS, D_MODEL, D_FF_EXPERT), D_MODEL),
        "moe_w2": nrm(ks[21], (n_moe, N_EXPERTS, D_FF_EXPERT, D_MODEL), D_FF_EXPERT, DEEPNORM_BETA),
    }


def reference(x, positions, w_in, b_forget, g_q_a, g_kv_a, w_q_b, w_kv_b,
              w_branch_moba, w_branch_fox, w_branch_mla, w_o, ln1_g, ln1_b, ln2_g, ln2_b,
              ffn_w1, ffn_w3, ffn_w2, moe_router, moe_w1, moe_w3, moe_w2):
    cos, sin = rope_tables(positions, x.dtype)
    for l in range(DEPTH):
        h = token_mixer(x, cos, sin, w_in[l], b_forget[l], g_q_a[l], g_kv_a[l], w_q_b[l], w_kv_b[l],
                        w_branch_moba[l], w_branch_fox[l], w_branch_mla[l], w_o[l])
        x = layer_norm(DEEPNORM_ALPHA * x + h, ln1_g[l], ln1_b[l])
        if l % 2 == 0:
            f = swiglu(x, ffn_w1[l // 2], ffn_w3[l // 2], ffn_w2[l // 2])
        else:
            f = moe_swiglu(x, moe_router[l // 2], moe_w1[l // 2], moe_w3[l // 2], moe_w2[l // 2])
        x = layer_norm(DEEPNORM_ALPHA * x + f, ln2_g[l], ln2_b[l])
    return x
```

```cpp
#include <hip/hip_runtime.h>
#include <cstdio>
#include <cstdint>
#include <type_traits>

#ifndef MK_N_LAUNCHES
#define MK_N_LAUNCHES 1
#endif
#ifndef PH_ENABLE
#define PH_ENABLE 0xFFFF
#endif
#define EN(k) (((PH_ENABLE) >> (k)) & 1)
#ifndef PROBE_REPEAT
#define PROBE_REPEAT 0
#endif
#define NREP(k) ((((PROBE_REPEAT) >> (k)) & 1) ? 2 : 1)
#ifndef ATT_MODES
#define ATT_MODES 7
#endif

#define GAS __attribute__((address_space(1)))
#define LAS __attribute__((address_space(3)))
typedef unsigned short bf16_t;
typedef short bf16x8 __attribute__((ext_vector_type(8)));
typedef short s16x4 __attribute__((ext_vector_type(4)));
typedef float f32x4 __attribute__((ext_vector_type(4)));
typedef float f32x2 __attribute__((ext_vector_type(2)));
typedef float f32x16 __attribute__((ext_vector_type(16)));
typedef unsigned u32x4 __attribute__((ext_vector_type(4)));
typedef unsigned u32x2 __attribute__((ext_vector_type(2)));

constexpr int NBATCH = 4, SEQ = 4096, DM = 2048, MTOK = NBATCH * SEQ, NHEAD = 8, HD = 128;
constexpr int NPROJ = 13568;
constexpr int C_MOBA = 0, C_FOX = 3072, C_CQ = 6144, C_CKV = 6656, C_GATE = 7168, C_SPEC = 13312;
constexpr int SRC_FORGET = 6144, SRC_CQ = 6152, SRC_CKV = 6664, SRC_KROPE = 7176, SRC_GATE = 7240, SRC_NPROJ = 13384;
constexpr int QLORA = 512, NQM = 1536, NKVM = 2048;
constexpr int DFF = 5632, DFFE = 7168, NEXP = 8;
constexpr int NOATT = 3072;
constexpr float ALPHA = 1.4142135623730951f;
constexpr float LN_EPS = 1e-5f, RMS_EPS = 1e-6f;
constexpr float LOG2E = 1.4426950408889634f;
constexpr float C2_128 = 0.12751743082459868f;
constexpr float C2_192 = 0.10411754627697264f;
constexpr float W13_SCALE = 256.f, W2_SCALE = 1024.f, X_SCALE = 8.f, H_SCALE = 4.f;
constexpr int MOE_MAXT = 136;

constexpr size_t MiB = 1u << 20;
constexpr size_t WS_CTL = 0, CTL_ZERO_BYTES = 1 * MiB;
constexpr size_t WS_COS = 1 * MiB, WS_SIN = 3 * MiB;
constexpr size_t WS_SSQ = 5 * MiB;
constexpr size_t WS_LF = 6 * MiB;
constexpr size_t WS_CB = 6 * MiB + 512 * 1024;
constexpr size_t WS_KMH = 7 * MiB, WS_KML = 7 * MiB + 128 * 1024;
constexpr size_t WS_LTOK = 8 * MiB, WS_LDST = 8 * MiB + 512 * 1024, WS_LGATE = 9 * MiB;
constexpr size_t WS_KPE = 10 * MiB;
constexpr size_t WS_WQB = 16 * MiB;
constexpr size_t WS_WKVB = 19 * MiB;
constexpr size_t WS_WBR = 23 * MiB;
constexpr size_t WS_WO = 47 * MiB;
constexpr size_t WS_WIN = 63 * MiB;
constexpr size_t WS_WF13 = 169 * MiB;
constexpr size_t WS_WF2 = 213 * MiB;
constexpr size_t WS_WM13 = 235 * MiB;
constexpr size_t WS_WM2 = 459 * MiB;
constexpr size_t WS_X1F = 571 * MiB;
constexpr size_t WS_XGF = 604 * MiB;
constexpr size_t WS_XBF = 672 * MiB;
constexpr size_t WS_WINF = 704 * MiB;
constexpr int NWIN16 = 29 * 256;
constexpr size_t WS_XB = 907 * MiB;
constexpr size_t WS_X1 = 972 * MiB;
constexpr size_t WS_PROJ = 1037 * MiB;
constexpr size_t WS_QM = 1461 * MiB;
constexpr size_t WS_KVM = 1509 * MiB;
constexpr size_t WS_HID = WS_PROJ;
constexpr size_t WS_OATT = 1573 * MiB;
constexpr size_t WS_MERGED = 1669 * MiB;
constexpr size_t WS_YMOE = WS_OATT;
constexpr size_t WS_Y = 1733 * MiB;
constexpr size_t WS_END = 1870 * MiB;
static_assert(WS_PROJ + (size_t)MTOK * NPROJ * 2 <= WS_QM && WS_HID + (size_t)(MOE_MAXT * 256) * DFFE * 2 <= WS_OATT, "ws map");
static_assert(WS_XGF + (size_t)(MOE_MAXT * 256) * DM <= 907 * MiB, "ws map");
constexpr int CW_CNT = 64;
constexpr int CW_BAR = 4096;

constexpr int RING_BYTES = 131072;
constexpr int MISC_OFF = RING_BYTES + 320;
constexpr int LDS_BYTES = 147456;
constexpr int NWAVES = 8;

#define RLX_AGENT __ATOMIC_RELAXED, __HIP_MEMORY_SCOPE_AGENT
#define LDS_WAIT() asm volatile("s_waitcnt lgkmcnt(0)" ::: "memory")
#define VM_WAIT() asm volatile("s_waitcnt vmcnt(0)" ::: "memory")
#define SBAR() __builtin_amdgcn_sched_barrier(0)
__device__ __forceinline__ unsigned cvt_pk_bf16(float lo, float hi) { unsigned r; asm volatile("v_cvt_pk_bf16_f32 %0, %1, %2" : "=v"(r) : "v"(lo), "v"(hi)); return r; }
__device__ __forceinline__ u32x4 pack8(f32x4 a, f32x4 b) { u32x4 w; w.x = cvt_pk_bf16(a[0], a[1]); w.y = cvt_pk_bf16(a[2], a[3]); w.z = cvt_pk_bf16(b[0], b[1]); w.w = cvt_pk_bf16(b[2], b[3]); return w; }
__device__ __forceinline__ unsigned pk4_fp8(float a, float b, float c, float d) { int w = 0; w = __builtin_amdgcn_cvt_pk_fp8_f32(a, b, w, false); w = __builtin_amdgcn_cvt_pk_fp8_f32(c, d, w, true); return (unsigned)w; }
__device__ __forceinline__ float bf_lo(unsigned w) { return __uint_as_float(w << 16); }
__device__ __forceinline__ float bf_hi(unsigned w) { return __uint_as_float(w & 0xffff0000u); }
__device__ __forceinline__ void unpack8(u32x4 w, f32x4& a, f32x4& b) { a[0] = bf_lo(w.x); a[1] = bf_hi(w.x); a[2] = bf_lo(w.y); a[3] = bf_hi(w.y); b[0] = bf_lo(w.z); b[1] = bf_hi(w.z); b[2] = bf_lo(w.w); b[3] = bf_hi(w.w); }
__device__ __forceinline__ float fast_sigmoid(float x) { return __builtin_amdgcn_rcpf(1.0f + __builtin_amdgcn_exp2f(-x * LOG2E)); }
template <int X> __device__ __forceinline__ float swz_xor(float v) { return __int_as_float(__builtin_amdgcn_ds_swizzle(__float_as_int(v), (X << 10) | 0x1f)); }
__device__ __forceinline__ float sum_xor32(float v) { auto rr = __builtin_amdgcn_permlane32_swap(__float_as_uint(v), __float_as_uint(v), false, false); return __uint_as_float(rr[0]) + __uint_as_float(rr[1]); }
__device__ __forceinline__ float wave_sum(float v) { v += swz_xor<1>(v); v += swz_xor<2>(v); v += swz_xor<4>(v); v += swz_xor<8>(v); v += swz_xor<16>(v); return sum_xor32(v); }

__device__ __forceinline__ unsigned char* assume_global(unsigned char* p) {
#if defined(__HIP_DEVICE_COMPILE__)
    __builtin_assume(!__builtin_amdgcn_is_shared((const __attribute__((address_space(0))) void*)p) && !__builtin_amdgcn_is_private((const __attribute__((address_space(0))) void*)p));
#endif
    return p;
}
__device__ __forceinline__ int my_tid(int wave0) { int lane; asm volatile("v_mbcnt_lo_u32_b32 %0, -1, 0\n\tv_mbcnt_hi_u32_b32 %0, -1, %0" : "=v"(lane)); return wave0 * 64 + lane; }

namespace pg8 {
constexpr int BM = 256, BK = 64, HALF = 128, HTB = HALF * BK * 2, STAGE_BYTES = 8 * HTB, NXCD = 8, WGM = 8;
__host__ __device__ __forceinline__ int lds_byte(int r, int c) { const int st = (r >> 4) * 2 + (c >> 5), rr = r & 15, cc = c & 31, ob = rr * 64 + cc * 2; return st * 1024 + (ob ^ (((ob >> 9) & 1) << 5)); }
__host__ __device__ __forceinline__ void stage_rc(int b, int& R, int& C) { const int st = b / 1024, sb = b % 1024, swz = sb ^ (((sb >> 9) & 1) << 5); R = (st >> 1) * 16 + swz / 64; C = (st & 1) * 32 + (swz % 64) / 2; }
__host__ __device__ __forceinline__ int perm32(int rho) { const int n = rho >> 4, i = rho & 15; return 8 * (i >> 2) + 4 * n + (i & 3); }

struct Unit { int pm, pn, tag; unsigned A, B; };
struct Shape { int K, lda, ldb; };

__device__ __forceinline__ void tile_map(int L, int nM, int nN, int& pm, int& pn) {
    const int nwg = nM * nN; int wgid = L;
    { const int q = nwg / NXCD, r = nwg % NXCD, xcd = wgid % NXCD, off = wgid / NXCD; wgid = (xcd < r ? xcd * (q + 1) : r * (q + 1) + (xcd - r) * q) + off; }
    const int nig = WGM * nN, gid = wgid / nig, fm = gid * WGM, gsz = (nM - fm) < WGM ? (nM - fm) : WGM;
    pm = __builtin_amdgcn_readfirstlane(fm + ((wgid % nig) % gsz)); pn = __builtin_amdgcn_readfirstlane((wgid % nig) / gsz);
}

__device__ __forceinline__ const char* uni_ptr(const char* p) { const unsigned long long v = (unsigned long long)p; const unsigned lo = __builtin_amdgcn_readfirstlane((unsigned)v), hi = __builtin_amdgcn_readfirstlane((unsigned)(v >> 32)); return (const char*)(((unsigned long long)hi << 32) | lo); }
__device__ __forceinline__ void glds16_s(const char* sbase, unsigned voff, unsigned lds_dst) { unsigned keep;
    asm volatile("s_mov_b32 %0, m0\n\ts_mov_b32 m0, %3\n\ts_nop 0\n\tglobal_load_lds_dwordx4 %1, %2\n\ts_mov_b32 m0, %0" : "=&s"(keep) : "v"(voff), "s"(sbase), "s"(lds_dst) : "memory"); }
typedef int i32x8 __attribute__((ext_vector_type(8)));
typedef int i32x4 __attribute__((ext_vector_type(4)));
__device__ __forceinline__ i32x8 cat8(bf16x8 a, bf16x8 b) { return __builtin_shufflevector(__builtin_bit_cast(i32x4, a), __builtin_bit_cast(i32x4, b), 0, 1, 2, 3, 4, 5, 6, 7); }
template <class Epi, class Sched, bool FP8 = false>
__device__ __forceinline__ void gemm_phase(LAS unsigned char* lds, const char* wsb, int wave0, const Shape g, const Sched& S, const Epi& E) {
    const int tid = my_tid(wave0);
    const int wid = __builtin_amdgcn_readfirstlane(tid >> 6), lane = tid & 63, wr = wid >> 2, wc = wid & 3, fr = lane & 15, fq = lane >> 4;
    const int K = g.K, nt = K / BK;
    unsigned voffA[2], voffB[2];
#pragma unroll
    for (int i = 0; i < 2; ++i) { int R, C; stage_rc(tid * 16 + i * 8192, R, C); const int Rb = Epi::PERM ? ((R & ~31) + perm32(R & 31)) : R;
        voffA[i] = (unsigned)(R * g.lda + C) * 2u; voffB[i] = (unsigned)(Rb * g.ldb + C) * 2u; }
    const unsigned kstep = (unsigned)(BK * 2);
    const unsigned hstepA = (unsigned)HALF * g.lda * 2, hstepB = (unsigned)HALF * g.ldb * 2;
    const unsigned ldsw = (unsigned)wid * 1024u; const unsigned ldsbase = (unsigned)(size_t)lds;
    const int aoff = lds_byte(wr * 64 + fr, fq * 8), boff = lds_byte(wc * 32 + fr, fq * 8);
#define PG8_SA(b, h) (((b) * 2 + (h)) * HTB)
#define PG8_SB(b, h) ((4 + (b) * 2 + (h)) * HTB)
#define PG8_STAGE(bufoff, goff, voff) do { _Pragma("unroll") for (int _i = 0; _i < 2; ++_i) glds16_s(wsb, (voff)[_i] + (unsigned)(goff), ldsbase + (unsigned)((bufoff) + _i * 8192) + ldsw); } while (0)
#define PG8_LDA(dst, b, h) do { _Pragma("unroll") for (int m = 0; m < 4; ++m) { \
        if constexpr (FP8) { const i32x4 lo_ = *(const LAS i32x4*)(lds + PG8_SA(b, h) + aoff + m * 2048), hi_ = *(const LAS i32x4*)(lds + PG8_SA(b, h) + aoff + m * 2048 + 1024); dst##8[m] = __builtin_shufflevector(lo_, hi_, 0, 1, 2, 3, 4, 5, 6, 7); } \
        else { _Pragma("unroll") for (int k = 0; k < 2; ++k) dst[m][k] = *(const LAS bf16x8*)(lds + PG8_SA(b, h) + aoff + m * 2048 + k * 1024); } } } while (0)
#define PG8_LDB(dst, b, h) do { _Pragma("unroll") for (int n = 0; n < 2; ++n) { \
        if constexpr (FP8) { const i32x4 lo_ = *(const LAS i32x4*)(lds + PG8_SB(b, h) + boff + n * 2048), hi_ = *(const LAS i32x4*)(lds + PG8_SB(b, h) + boff + n * 2048 + 1024); dst##8[n] = __builtin_shufflevector(lo_, hi_, 0, 1, 2, 3, 4, 5, 6, 7); } \
        else { _Pragma("unroll") for (int k = 0; k < 2; ++k) dst[n][k] = *(const LAS bf16x8*)(lds + PG8_SB(b, h) + boff + n * 2048 + k * 1024); } } } while (0)
#define PG8_MMA(ai, bj, At, Bt) do { __builtin_amdgcn_s_setprio(1); \
        if constexpr (FP8) { _Pragma("unroll") for (int m = 0; m < 4; ++m) _Pragma("unroll") for (int n = 0; n < 2; ++n) \
            acc[ai][bj][m][n] = __builtin_amdgcn_mfma_scale_f32_16x16x128_f8f6f4(Bt##8[n], At##8[m], acc[ai][bj][m][n], 0, 0, 0, 0, 0, 0); } \
        else { _Pragma("unroll") for (int m = 0; m < 4; ++m) _Pragma("unroll") for (int n = 0; n < 2; ++n) _Pragma("unroll") for (int k = 0; k < 2; ++k) \
            acc[ai][bj][m][n] = __builtin_amdgcn_mfma_f32_16x16x32_bf16(Bt[n][k], At[m][k], acc[ai][bj][m][n], 0, 0, 0); } \
        __builtin_amdgcn_s_setprio(0); } while (0)
#define PG8_WAIT_V(n) asm volatile("s_waitcnt vmcnt(" #n ")" ::: "memory")
#define PG8_WAIT_L(n) asm volatile("s_waitcnt lgkmcnt(" #n ")" ::: "memory")
#define PG8_BAR __builtin_amdgcn_s_barrier()
#define PG8_SCHED __builtin_amdgcn_sched_barrier(0)
    Unit cur, nxt; int ui = 0;
    if (!S.next(0, cur)) return;
    f32x4 acc[2][2][4][2];
#define PG8_ZERO_ACC() do { _Pragma("unroll") for (int a = 0; a < 2; ++a) _Pragma("unroll") for (int b = 0; b < 2; ++b) _Pragma("unroll") for (int m = 0; m < 4; ++m) _Pragma("unroll") for (int n = 0; n < 2; ++n) \
        _Pragma("unroll") for (int j = 0; j < 4; ++j) { float z_; asm volatile("v_mov_b32 %0, 0" : "=v"(z_)); acc[a][b][m][n][j] = z_; } } while (0)
    PG8_ZERO_ACC();
    bf16x8 At[4][2], B0[2][2], B1[2][2]; i32x8 At8[4], B08[2], B18[2]; (void)At; (void)B0; (void)B1; (void)At8; (void)B08; (void)B18;
    unsigned cA = __builtin_amdgcn_readfirstlane(cur.A), cB = __builtin_amdgcn_readfirstlane(cur.B);
    PG8_STAGE(PG8_SB(0, 0), cB, voffB); PG8_STAGE(PG8_SB(0, 1), cB + hstepB, voffB); PG8_STAGE(PG8_SA(0, 0), cA, voffA); PG8_STAGE(PG8_SA(0, 1), cA + hstepA, voffA);
    if (wr == 1) PG8_BAR;
    PG8_WAIT_V(2); PG8_BAR;
    PG8_STAGE(PG8_SB(1, 0), cB + kstep, voffB); PG8_STAGE(PG8_SA(1, 0), cA + kstep, voffA); PG8_STAGE(PG8_SB(1, 1), cB + hstepB + kstep, voffB);
    PG8_WAIT_V(6); PG8_BAR;
    for (;;) {
        const bool has_next = S.next(ui + 1, nxt);
        const unsigned nA = has_next ? __builtin_amdgcn_readfirstlane(nxt.A) : cA, nB = has_next ? __builtin_amdgcn_readfirstlane(nxt.B) : cB;
        for (int t = 0; t < nt; t += 2) {
            const bool last = (t == nt - 2);
            const unsigned a1 = cA + (unsigned)(t + 1) * kstep;
            const unsigned a2 = last ? nA : cA + (unsigned)(t + 2) * kstep, b2 = last ? nB : cB + (unsigned)(t + 2) * kstep;
            const unsigned a3 = a2 + kstep, b3 = b2 + kstep;
            PG8_LDB(B0, 0, 0); PG8_LDB(B1, 0, 1); PG8_SCHED; PG8_LDA(At, 0, 0); PG8_STAGE(PG8_SA(1, 1), a1 + hstepA, voffA);
            PG8_WAIT_V(8); PG8_WAIT_L(0); PG8_BAR; PG8_MMA(0, 0, At, B0); PG8_MMA(0, 1, At, B1); PG8_BAR; PG8_SCHED;
            PG8_LDA(At, 0, 1); PG8_STAGE(PG8_SB(0, 0), b2, voffB); PG8_STAGE(PG8_SB(0, 1), b2 + hstepB, voffB); PG8_STAGE(PG8_SA(0, 0), a2, voffA);
            PG8_WAIT_V(8); PG8_WAIT_L(0); PG8_BAR; PG8_MMA(1, 0, At, B0); PG8_MMA(1, 1, At, B1); PG8_BAR; PG8_SCHED;
            PG8_LDB(B0, 1, 0); PG8_LDB(B1, 1, 1); PG8_SCHED; PG8_LDA(At, 1, 0); PG8_STAGE(PG8_SA(0, 1), a2 + hstepA, voffA);
            PG8_WAIT_V(8); PG8_WAIT_L(0); PG8_BAR; PG8_MMA(0, 0, At, B0); PG8_MMA(0, 1, At, B1); PG8_BAR; PG8_SCHED;
            PG8_LDA(At, 1, 1); PG8_STAGE(PG8_SB(1, 0), b3, voffB); PG8_STAGE(PG8_SB(1, 1), b3 + hstepB, voffB); PG8_STAGE(PG8_SA(1, 0), a3, voffA);
            PG8_WAIT_V(8); PG8_WAIT_L(0); PG8_BAR; PG8_MMA(1, 0, At, B0); PG8_MMA(1, 1, At, B1); PG8_BAR; PG8_SCHED;
        }
        if (wr == 0) PG8_BAR;
        { const int l2 = my_tid(wave0) & 63;
          E(acc, cur, wr, wc, l2 & 15, l2 >> 4); }
        if (!has_next) break;
        PG8_ZERO_ACC();
        cur = nxt; cA = nA; cB = nB; ++ui;
        if (wr == 1) PG8_BAR;
    }
    PG8_WAIT_V(0);
    PG8_BAR;
#undef PG8_ZERO_ACC
#undef PG8_SA
#undef PG8_SB
#undef PG8_STAGE
#undef PG8_LDA
#undef PG8_LDB
#undef PG8_MMA
#undef PG8_WAIT_V
#undef PG8_WAIT_L
#undef PG8_BAR
#undef PG8_SCHED
}
}

struct SchedPlain {
    int nM, nN, G, c; unsigned A, B, tA, tB;
    __device__ __forceinline__ bool next(int i, pg8::Unit& u) const {
        const long L = (long)i * G + c; if (L >= (long)nM * nN) return false;
        pg8::tile_map((int)L, nM, nN, u.pm, u.pn); u.tag = 0; u.A = A + (unsigned)u.pm * tA; u.B = B + (unsigned)u.pn * tB; return true;
    }
};
struct SchedGates {
    int G, c; unsigned A, B;
    __device__ __forceinline__ bool next(int i, pg8::Unit& u) const {
        long L;
        if (G == 256) { if (i < 5) L = (long)i * 256 + c; else if (i == 5) { if (c < 64) return false; L = 1280 + (c - 64); } else if (i == 6) { if (c < 64 || c >= 128) return false; L = 1472 + (c - 64); } else return false; }
        else { L = (long)i * G + c; if (L >= 64 * 24) return false; }
        pg8::tile_map((int)L, 64, 24, u.pm, u.pn); u.tag = 0; u.A = A + (unsigned)u.pm * (256u * DM); u.B = B + (unsigned)u.pn * (256u * DM); return true;
    }
};
struct SchedMlaUp {
    int G, c; unsigned Aq, Akv, Bq, Bkv;
    __device__ __forceinline__ bool next(int i, pg8::Unit& u) const {
        const long L = (long)i * G + c; if (L >= 64 * 14) return false;
        int pm, pv; pg8::tile_map((int)L, 64, 14, pm, pv); u.pm = pm;
        const unsigned tA = 256u * NPROJ * 2, tB = 256u * QLORA * 2;
        if (pv < 6) { u.pn = pv; u.tag = 0; u.A = Aq + (unsigned)pm * tA; u.B = Bq + (unsigned)pv * tB; }
        else { u.pn = pv - 6; u.tag = 1; u.A = Akv + (unsigned)pm * tA; u.B = Bkv + (unsigned)(pv - 6) * tB; }
        return true;
    }
};
struct SchedMerge {
    int G, c; unsigned A, B;
    __device__ __forceinline__ bool next(int i, pg8::Unit& u) const {
        const int r = i / 3, br = i - 3 * r; const long L = (long)r * G + c; if (L >= 512) return false;
        pg8::tile_map((int)L, 64, 8, u.pm, u.pn); u.tag = br;
        u.A = A + (unsigned)u.pm * (256u * NOATT * 2) + (unsigned)br * 2048u; u.B = B + (unsigned)br * ((unsigned)DM * 1024 * 2) + (unsigned)u.pn * (256u * 1024 * 2); return true;
    }
};
struct SchedMoe {
    int nM, nN, G, c; unsigned A, B, tA, tB, eB; unsigned long long tbp;
    __device__ __forceinline__ bool next(int i, pg8::Unit& u) const {
        const long L = (long)i * G + c; if (L >= (long)nM * nN) return false;
        pg8::tile_map((int)L, nM, nN, u.pm, u.pn); int e = 0;
#pragma unroll
        for (int j = 0; j < 7; ++j) e += (u.pm >= (int)((tbp >> (8 * j)) & 255ull)) ? 1 : 0;
        e = __builtin_amdgcn_readfirstlane(e);
        u.tag = e; u.A = A + (unsigned)u.pm * tA; u.B = B + (unsigned)e * eB + (unsigned)u.pn * tB; return true;
    }
};

struct EpiInProj {
    static constexpr bool PERM = true;
    bf16_t* proj; float* ssq; const float* cosT; const float* sinT; bf16_t* kpe; float* lf; const float* bforget;
    __device__ __forceinline__ void operator()(const f32x4 (&acc)[2][2][4][2], const pg8::Unit& u, int wr, int wc, int fr, int fq) const {
        const int row0 = u.pm * 256 + wr * 64 + fr, col0 = wc * 32 + 8 * fq;
        if (u.pn < 28) {
            const float sc = __int_as_float(__builtin_amdgcn_readfirstlane((u.pn < 4 || (u.pn >= 12 && u.pn < 16)) ? __float_as_int(C2_128) : __float_as_int(1.0f)));
            const bool dossq = (u.pn >= 24 && u.pn < 28);
#pragma unroll
            for (int ai = 0; ai < 2; ++ai)
#pragma unroll
                for (int m = 0; m < 4; ++m) { const int row = row0 + ai * 128 + m * 16; bf16_t* rowp = proj + (size_t)row * NPROJ + u.pn * 256 + col0; float s = 0.f;
#pragma unroll
                    for (int bj = 0; bj < 2; ++bj) { const f32x4 v0 = acc[ai][bj][m][0] * sc, v1 = acc[ai][bj][m][1] * sc;
                        s += (v0[0] * v0[0] + v0[1] * v0[1]) + (v0[2] * v0[2] + v0[3] * v0[3]) + (v1[0] * v1[0] + v1[1] * v1[1]) + (v1[2] * v1[2] + v1[3] * v1[3]);
                        *(u32x4*)(rowp + bj * 128) = pack8(v0, v1); }
                    if (dossq) { s += swz_xor<16>(s); s = sum_xor32(s); if (fq == 0) ssq[(size_t)row * 16 + (u.pn - 24) * 4 + wc] = s; } }
        } else {
            if (wc < 2) {
#pragma unroll
                for (int ai = 0; ai < 2; ++ai)
#pragma unroll
                    for (int m = 0; m < 4; ++m) { const int row = row0 + ai * 128 + m * 16; const int i0 = 16 * wc + 4 * fq;
                        const f32x4 cs = *(const f32x4*)(cosT + (size_t)row * 32 + i0), sn = *(const f32x4*)(sinT + (size_t)row * 32 + i0);
                        const f32x4 v0 = acc[ai][0][m][0], v1 = acc[ai][0][m][1]; f32x4 o0, o1;
                        o0[0] = v0[0] * cs[0] - v0[1] * sn[0]; o0[1] = v0[1] * cs[0] + v0[0] * sn[0]; o0[2] = v0[2] * cs[1] - v0[3] * sn[1]; o0[3] = v0[3] * cs[1] + v0[2] * sn[1];
                        o1[0] = v1[0] * cs[2] - v1[1] * sn[2]; o1[1] = v1[1] * cs[2] + v1[0] * sn[2]; o1[2] = v1[2] * cs[3] - v1[3] * sn[3]; o1[3] = v1[3] * cs[3] + v1[2] * sn[3];
                        *(u32x4*)(kpe + (size_t)row * 64 + col0) = pack8(o0, o1); }
            } else if (wc == 2 && fq == 0) {
                const f32x4 b0 = *(const f32x4*)(bforget), b1 = *(const f32x4*)(bforget + 4);
#pragma unroll
                for (int ai = 0; ai < 2; ++ai)
#pragma unroll
                    for (int m = 0; m < 4; ++m) { const int row = row0 + ai * 128 + m * 16; f32x4 z0 = acc[ai][0][m][0] + b0, z1 = acc[ai][0][m][1] + b1;
#pragma unroll
                        for (int j = 0; j < 4; ++j) { z0[j] = fminf(z0[j], 0.f) - log1pf(expf(-fabsf(z0[j]))); z1[j] = fminf(z1[j], 0.f) - log1pf(expf(-fabsf(z1[j]))); }
                        *(f32x4*)(lf + (size_t)row * 8) = z0; *(f32x4*)(lf + (size_t)row * 8 + 4) = z1; }
            }
        }
    }
};
struct EpiGates8 {
    static constexpr bool PERM = true;
    bf16_t* proj;
    __device__ __forceinline__ void operator()(const f32x4 (&acc)[2][2][4][2], const pg8::Unit& u, int wr, int wc, int fr, int fq) const {
        const int row0 = u.pm * 256 + wr * 64 + fr, col0 = C_GATE + u.pn * 256 + wc * 32 + 8 * fq; const float ds = 1.0f / (X_SCALE * W13_SCALE);
#pragma unroll
        for (int ai = 0; ai < 2; ++ai)
#pragma unroll
            for (int m = 0; m < 4; ++m) { bf16_t* rowp = proj + (size_t)(row0 + ai * 128 + m * 16) * NPROJ + col0;
#pragma unroll
                for (int bj = 0; bj < 2; ++bj) *(u32x4*)(rowp + bj * 128) = pack8(acc[ai][bj][m][0] * ds, acc[ai][bj][m][1] * ds); }
    }
};
struct EpiMlaUp {
    static constexpr bool PERM = true;
    bf16_t* qm; bf16_t* kvm; const float* ssq; const float* cosT; const float* sinT;
    __device__ __forceinline__ void operator()(const f32x4 (&acc)[2][2][4][2], const pg8::Unit& u, int wr, int wc, int fr, int fq) const {
        const int row0 = u.pm * 256 + wr * 64 + fr, col0 = wc * 32 + 8 * fq;
#pragma unroll
        for (int ai = 0; ai < 2; ++ai)
#pragma unroll
            for (int m = 0; m < 4; ++m) { const int row = row0 + ai * 128 + m * 16;
                const f32x4 s0 = *(const f32x4*)(ssq + (size_t)row * 16 + u.tag * 8), s1 = *(const f32x4*)(ssq + (size_t)row * 16 + u.tag * 8 + 4);
                const float ss = ((s0[0] + s0[1]) + (s0[2] + s0[3])) + ((s1[0] + s1[1]) + (s1[2] + s1[3]));
                float rs = 1.0f / sqrtf(ss * (1.0f / 512.0f) + RMS_EPS);
                if (u.tag == 0) {
                    rs *= C2_192; bf16_t* rowp = qm + (size_t)row * NQM + u.pn * 256 + col0;
                    if (u.pn < 4) {
#pragma unroll
                        for (int bj = 0; bj < 2; ++bj) *(u32x4*)(rowp + bj * 128) = pack8(acc[ai][bj][m][0] * rs, acc[ai][bj][m][1] * rs);
                    } else {
#pragma unroll
                        for (int bj = 0; bj < 2; ++bj) { const int jj = (bj * 128 + col0) & 63, i0 = jj >> 1;
                            const f32x4 cs = *(const f32x4*)(cosT + (size_t)row * 32 + i0), sn = *(const f32x4*)(sinT + (size_t)row * 32 + i0);
                            const f32x4 v0 = acc[ai][bj][m][0] * rs, v1 = acc[ai][bj][m][1] * rs; f32x4 o0, o1;
                            o0[0] = v0[0] * cs[0] - v0[1] * sn[0]; o0[1] = v0[1] * cs[0] + v0[0] * sn[0]; o0[2] = v0[2] * cs[1] - v0[3] * sn[1]; o0[3] = v0[3] * cs[1] + v0[2] * sn[1];
                            o1[0] = v1[0] * cs[2] - v1[1] * sn[2]; o1[1] = v1[1] * cs[2] + v1[0] * sn[2]; o1[2] = v1[2] * cs[3] - v1[3] * sn[3]; o1[3] = v1[3] * cs[3] + v1[2] * sn[3];
                            *(u32x4*)(rowp + bj * 128) = pack8(o0, o1); }
                    }
                } else {
                    bf16_t* rowp = kvm + (size_t)row * NKVM + u.pn * 256 + col0;
#pragma unroll
                    for (int bj = 0; bj < 2; ++bj) *(u32x4*)(rowp + bj * 128) = pack8(acc[ai][bj][m][0] * rs, acc[ai][bj][m][1] * rs);
                }
            }
    }
};
struct EpiGateMerge {
    static constexpr bool PERM = true;
    const bf16_t* proj; bf16_t* merged;
    __device__ __forceinline__ void operator()(const f32x4 (&acc)[2][2][4][2], const pg8::Unit& u, int wr, int wc, int fr, int fq) const {
        const int row0 = u.pm * 256 + wr * 64 + fr, col0 = u.pn * 256 + wc * 32 + 8 * fq;
#pragma unroll
        for (int ai = 0; ai < 2; ++ai)
#pragma unroll
            for (int m = 0; m < 4; ++m) { const int row = row0 + ai * 128 + m * 16;
#pragma unroll
                for (int bj = 0; bj < 2; ++bj) { const int col = col0 + bj * 128;
                    const u32x4 gw = *(const u32x4*)(proj + (size_t)row * NPROJ + C_GATE + u.tag * 2048 + col); f32x4 g0, g1; unpack8(gw, g0, g1);
                    f32x4 v0 = acc[ai][bj][m][0], v1 = acc[ai][bj][m][1];
#pragma unroll
                    for (int j = 0; j < 4; ++j) { v0[j] *= fast_sigmoid(g0[j]); v1[j] *= fast_sigmoid(g1[j]); }
                    bf16_t* op = merged + (size_t)row * DM + col;
                    if (u.tag > 0) { const u32x4 pw = *(const u32x4*)op; f32x4 p0, p1; unpack8(pw, p0, p1); v0 += p0; v1 += p1; }
                    *(u32x4*)op = pack8(v0, v1); } }
    }
};
struct EpiResidual {
    static constexpr bool PERM = true;
    const bf16_t* res; bf16_t* y;
    __device__ __forceinline__ void operator()(const f32x4 (&acc)[2][2][4][2], const pg8::Unit& u, int wr, int wc, int fr, int fq) const {
        const int row0 = u.pm * 256 + wr * 64 + fr, col0 = u.pn * 256 + wc * 32 + 8 * fq;
#pragma unroll
        for (int ai = 0; ai < 2; ++ai)
#pragma unroll
            for (int m = 0; m < 4; ++m) { const size_t off = (size_t)(row0 + ai * 128 + m * 16) * DM + col0;
#pragma unroll
                for (int bj = 0; bj < 2; ++bj) { const u32x4 rw = *(const u32x4*)(res + off + bj * 128); f32x4 r0, r1; unpack8(rw, r0, r1);
                    *(u32x4*)(y + off + bj * 128) = pack8(r0 * ALPHA + acc[ai][bj][m][0], r1 * ALPHA + acc[ai][bj][m][1]); } }
    }
};
struct EpiSwiGLU {
    static constexpr bool PERM = true;
    bf16_t* hid; int ldh;
    __device__ __forceinline__ void operator()(const f32x4 (&acc)[2][2][4][2], const pg8::Unit& u, int wr, int wc, int fr, int fq) const {
        const int row0 = u.pm * 256 + wr * 64 + fr, col0 = u.pn * 128 + wc * 32 + 8 * fq;
#pragma unroll
        for (int ai = 0; ai < 2; ++ai)
#pragma unroll
            for (int m = 0; m < 4; ++m) { f32x4 h0, h1;
#pragma unroll
                for (int j = 0; j < 4; ++j) { const float a0 = acc[ai][0][m][0][j], a1 = acc[ai][0][m][1][j];
                    h0[j] = a0 * fast_sigmoid(a0) * acc[ai][1][m][0][j]; h1[j] = a1 * fast_sigmoid(a1) * acc[ai][1][m][1][j]; }
                *(u32x4*)(hid + (size_t)(row0 + ai * 128 + m * 16) * ldh + col0) = pack8(h0, h1); }
    }
};
struct EpiSwiGLU8 {
    static constexpr bool PERM = true;
    unsigned char* hid; int ldh;
    __device__ __forceinline__ void operator()(const f32x4 (&acc)[2][2][4][2], const pg8::Unit& u, int wr, int wc, int fr, int fq) const {
        const int row0 = u.pm * 256 + wr * 64 + fr, col0 = u.pn * 128 + wc * 32 + 8 * fq; const float ds = 1.0f / (X_SCALE * W13_SCALE);
#pragma unroll
        for (int ai = 0; ai < 2; ++ai)
#pragma unroll
            for (int m = 0; m < 4; ++m) { f32x4 h0, h1;
#pragma unroll
                for (int j = 0; j < 4; ++j) { const float a0 = acc[ai][0][m][0][j] * ds, a1 = acc[ai][0][m][1][j] * ds;
                    h0[j] = a0 * fast_sigmoid(a0) * (acc[ai][1][m][0][j] * (ds * H_SCALE)); h1[j] = a1 * fast_sigmoid(a1) * (acc[ai][1][m][1][j] * (ds * H_SCALE)); }
                u32x2 w; w.x = pk4_fp8(h0[0], h0[1], h0[2], h0[3]); w.y = pk4_fp8(h1[0], h1[1], h1[2], h1[3]);
                *(u32x2*)(hid + (size_t)(row0 + ai * 128 + m * 16) * ldh + col0) = w; }
    }
};
struct EpiMoeDown {
    static constexpr bool PERM = true;
    bf16_t* ymoe; const int* ldst; const float* lgate; unsigned long long tbp; const unsigned* cntp;
    __device__ __forceinline__ void operator()(const f32x4 (&acc)[2][2][4][2], const pg8::Unit& u, int wr, int wc, int fr, int fq) const {
        const int e = u.tag; const int tbe = (int)((tbp >> (8 * e)) & 255ull);
        int ce = (int)__hip_atomic_load(cntp + e, RLX_AGENT); if (ce > MTOK) ce = MTOK;
        const int pos0 = (u.pm - tbe) * 256 + wr * 64 + fr, col0 = u.pn * 256 + wc * 32 + 8 * fq;
#pragma unroll
        for (int ai = 0; ai < 2; ++ai)
#pragma unroll
            for (int m = 0; m < 4; ++m) { const int pos = pos0 + ai * 128 + m * 16;
                if (pos < ce) { const int dst = ldst[e * MTOK + pos]; const float gt = lgate[e * MTOK + pos] * (1.0f / (H_SCALE * W2_SCALE)); bf16_t* rowp = ymoe + (size_t)dst * DM + col0;
#pragma unroll
                    for (int bj = 0; bj < 2; ++bj) *(u32x4*)(rowp + bj * 128) = pack8(acc[ai][bj][m][0] * gt, acc[ai][bj][m][1] * gt); } }
    }
};

namespace att {
constexpr int KVBLK = 64, QBLK = 32, QB = 256;
constexpr int SHM_V = 16384, SHM_K = 16384, SHM_KPE = 8192;
constexpr int L_V = 0, L_K = 2 * SHM_V, L_KPE = L_K + 3 * SHM_K, L_BIAS = L_KPE + 3 * SHM_KPE, L_TAB = L_BIAS + 768, L_WS = L_TAB + 256, L_NEED = L_WS + 8 * 256, L_END = L_NEED + 256, L_OST = 0;
static_assert(L_END <= RING_BYTES, "attention LDS");
constexpr float THRL = 8.0f;
#define KSWZ(row, colB) ((row) * 256 + ((colB) ^ (((row) & 7) << 4)))
__device__ __forceinline__ int v_st(int k, int c) { const int kk = (k & ~0xC) | ((k & 4) << 1) | ((k & 8) >> 1); return ((kk >> 3) * 4 + (c >> 5)) * 512 + ((kk & 7) * 32 + (c & 31)) * 2; }
__device__ __forceinline__ int v_rd_base(int lane) { return ((lane & 3) << 3) | (((lane >> 2) & 3) << 6) | (((lane >> 4) & 1) << 5) | (((lane >> 5) & 1) << 8); }
__device__ __forceinline__ int crow(int r, int hi) { return (r & 3) + 8 * (r >> 2) + 4 * hi; }
enum { MOBA = 0, FOX = 1, MLA = 2 };
struct Args { const bf16_t* q; int ldq; const bf16_t* qr; const bf16_t* k; int ldk; const bf16_t* kr; const bf16_t* v; int ldv; bf16_t* o; const float* cb; const bf16_t* kmh; const bf16_t* kml; };

template <int MODE>
__device__ __forceinline__ void attn_unit(const Args& a, int b, int h, int qb, LAS unsigned char* lds, int wave0) {
    const int tid = my_tid(wave0);
    const int wid = __builtin_amdgcn_readfirstlane(tid >> 6), lane = tid & 63, r32 = lane & 31, hi = lane >> 5;
    const size_t rowbase = (size_t)b * SEQ; const int q0 = qb * QB;
    LAS unsigned char* V_lds = lds + L_V; LAS unsigned char* K_lds = lds + L_K; LAS unsigned char* P_lds = lds + L_KPE;
    LAS float* bias_l = (LAS float*)(lds + L_BIAS); LAS float* tab_l = (LAS float*)(lds + L_TAB);
    LAS float* wsf = (LAS float*)(lds + L_WS) + wid * 64; LAS float* li_l = wsf; LAS float* al_l = wsf + 32;
    LAS unsigned* need_l = (LAS unsigned*)(lds + L_NEED);
    const bf16_t* Qg = a.q + (rowbase + q0 + wid * QBLK + r32) * (size_t)a.ldq + h * HD;
    const bf16_t* Kg = a.k + rowbase * (size_t)a.ldk + h * HD;
    const bf16_t* Vg = a.v + rowbase * (size_t)a.ldv + h * HD;
    bf16x8 qr[MODE == MLA ? 12 : 8];
#pragma unroll
    for (int d0 = 0; d0 < 8; ++d0) qr[d0] = *(const bf16x8*)(Qg + d0 * 16 + hi * 8);
    if constexpr (MODE == MLA) { const bf16_t* Qr = a.qr + (rowbase + q0 + wid * QBLK + r32) * (size_t)a.ldq + h * 64;
#pragma unroll
        for (int d0 = 0; d0 < 4; ++d0) qr[8 + d0] = *(const bf16x8*)(Qr + d0 * 16 + hi * 8); }
    int koff[2], voff[2], poff = 0;
#pragma unroll
    for (int j = 0; j < 2; ++j) { const int pc = wid * 2 + j;
        { const int row = pc * 4 + (lane >> 4), ch = (lane & 15) ^ (row & 7); koff[j] = row * a.ldk + ch * 8; }
        { const int st = pc * 2 + (lane >> 5), kk = (st >> 2) * 8 + ((lane & 31) >> 2), c = (st & 3) * 32 + (lane & 3) * 8; const int k = (kk & ~0xC) | ((kk & 4) << 1) | ((kk & 8) >> 1); voff[j] = k * a.ldv + c; } }
    if constexpr (MODE == MLA) { const int row = wid * 8 + (lane >> 3), ch = (lane & 7) ^ (row & 7); poff = row * 64 + ch * 8; }
    const int vb0 = (int)(uintptr_t)V_lds + v_rd_base(lane);
    const LAS unsigned char* kb4[4];
#pragma unroll
    for (int dd = 0; dd < 4; ++dd) kb4[dd] = K_lds + KSWZ(r32, (dd * 16 + hi * 8) * 2);
    const LAS unsigned char* pb4[4];
#pragma unroll
    for (int dd = 0; dd < 4; ++dd) pb4[dd] = P_lds + r32 * 128 + (((dd * 2 + hi) * 16) ^ ((r32 & 7) << 4));
    const int NBLK = qb + 1;
    unsigned need = (1u << NBLK) - 1u; unsigned selmask = need;
    float sl2 = 0.f;
    if constexpr (MODE == MOBA) {
        sl2 = __builtin_amdgcn_exp2f(-(float)(h + 1)) * LOG2E;
        if (tid < 64) tab_l[tid] = sl2 * (float)tid;
        if (tid == 0) need_l[0] = 0u;
        { const int sr = tid >> 4, sc = (tid & 15) * 8, kws = KSWZ(sr, sc * 2);
          const size_t kmoff = ((size_t)(b * NHEAD + h) * 16) * HD; u32x4 z;
#pragma unroll
          for (int j = 0; j < 4; ++j) { unsigned z_; asm volatile("v_mov_b32 %0, 0" : "=v"(z_)); z[j] = z_; }
          if (tid < 256) { *(LAS u32x4*)(K_lds + kws) = *(const u32x4*)(a.kmh + kmoff + (size_t)sr * HD + sc); *(LAS u32x4*)(K_lds + SHM_K + kws) = *(const u32x4*)(a.kml + kmoff + (size_t)sr * HD + sc); }
          else { *(LAS u32x4*)(K_lds + kws) = z; *(LAS u32x4*)(K_lds + SHM_K + kws) = z; } }
        __syncthreads();
        f32x16 g = {};
#pragma unroll
        for (int d0 = 0; d0 < 8; ++d0) { const LAS unsigned char* ap = kb4[d0 & 3] + (d0 >> 2) * 128;
            const bf16x8 kh = *(const LAS bf16x8*)ap, kl = *(const LAS bf16x8*)(ap + SHM_K);
            g = __builtin_amdgcn_mfma_f32_32x32x16_bf16(kh, qr[d0], g, 0, 0, 0); g = __builtin_amdgcn_mfma_f32_32x32x16_bf16(kl, qr[d0], g, 0, 0, 0); }
        float val[16];
#pragma unroll
        for (int i = 0; i < 8; ++i) { auto rr = __builtin_amdgcn_permlane32_swap(__float_as_uint(g[i]), __float_as_uint(g[i]), false, false);
            const int nlo = (i & 3) + 8 * (i >> 2); val[nlo] = __uint_as_float(rr[0]); val[nlo + 4] = __uint_as_float(rr[1]); }
        const float NEGI = -__builtin_inff();
#pragma unroll
        for (int n = 0; n < 16; ++n) if (n >= qb) val[n] = NEGI;
        unsigned sel = 0u;
#pragma unroll
        for (int pass = 0; pass < 3; ++pass) { float best = NEGI; int bi = -1;
#pragma unroll
            for (int n = 0; n < 16; ++n) if (val[n] > best) { best = val[n]; bi = n; }
#pragma unroll
            for (int n = 0; n < 16; ++n) if (n == bi) { val[n] = NEGI; sel |= (1u << n); } }
        selmask = sel | (1u << qb);
        unsigned wneed = 0u;
#pragma unroll
        for (int n = 0; n < 16; ++n) if (__ballot((selmask >> n) & 1u) != 0ull) wneed |= (1u << n);
        if (lane == 0) atomicOr((unsigned*)need_l, wneed);
        __syncthreads();
        need = (unsigned)__builtin_amdgcn_readfirstlane((int)need_l[0]);
    }
    float m_reg = -1e30f, l_reg = 0.f; f32x16 o[4] = {};
    const int qpos = q0 + wid * QBLK + r32;
    const int qlo = q0 + wid * QBLK;
    const LAS float* bt = (MODE == FOX) ? (const LAS float*)(bias_l + 4 * hi) : (const LAS float*)(tab_l + 4 * hi);
#define DMA_KT(kb, KI) do { \
        _Pragma("unroll") for (int j_ = 0; j_ < 2; ++j_) \
            __builtin_amdgcn_global_load_lds((const unsigned*)(Kg + (size_t)(kb) * a.ldk + koff[j_]), (LAS unsigned*)(K_lds + (KI) * SHM_K + (wid * 2 + j_) * 1024), 16, 0, 0); \
        if constexpr (MODE == MLA) __builtin_amdgcn_global_load_lds((const unsigned*)(a.kr + (rowbase + (kb)) * 64 + poff), (LAS unsigned*)(P_lds + (KI) * SHM_KPE + wid * 1024), 16, 0, 0); \
        if constexpr (MODE == FOX) { if (wid == 0) __builtin_amdgcn_global_load_lds((const unsigned*)(a.cb + (size_t)(b * NHEAD + h) * SEQ + (kb) + lane), (LAS unsigned*)(bias_l + (KI) * 64), 4, 0, 0); } } while (0)
#define DMA_VT(kb, VI) do { \
        _Pragma("unroll") for (int j_ = 0; j_ < 2; ++j_) \
            __builtin_amdgcn_global_load_lds((const unsigned*)(Vg + (size_t)(kb) * a.ldv + voff[j_]), (LAS unsigned*)(V_lds + (VI) * SHM_V + (wid * 2 + j_) * 1024), 16, 0, 0); } while (0)
#define PK4(P, B_, OUT) do { unsigned a0_ = cvt_pk_bf16(P[B_ + 0], P[B_ + 1]), a1_ = cvt_pk_bf16(P[B_ + 2], P[B_ + 3]), b0_ = cvt_pk_bf16(P[B_ + 4], P[B_ + 5]), b1_ = cvt_pk_bf16(P[B_ + 6], P[B_ + 7]); \
        auto r0_ = __builtin_amdgcn_permlane32_swap(a0_, b0_, false, false); auto r1_ = __builtin_amdgcn_permlane32_swap(a1_, b1_, false, false); \
        u32x4 w_ = {r0_[0], r1_[0], r0_[1], r1_[1]}; OUT = __builtin_bit_cast(bf16x8, w_); } while (0)
#define TRRD(dst, off_) asm volatile("ds_read_b64_tr_b16 %0, %1 offset:%2" : "=&v"(dst) : "v"(vb), "i"(off_) : "memory")
#define PV_D0(d0) do { s16x4 l0, l1, l2, l3, h0, h1, h2, h3; constexpr int b_ = (d0) * 512; \
        TRRD(l0, b_); TRRD(h0, b_ + 2048); TRRD(l1, b_ + 4096); TRRD(h1, b_ + 6144); TRRD(l2, b_ + 8192); TRRD(h2, b_ + 10240); TRRD(l3, b_ + 12288); TRRD(h3, b_ + 14336); \
        asm volatile("s_waitcnt lgkmcnt(0)" ::: "memory"); SBAR(); \
        o[d0] = __builtin_amdgcn_mfma_f32_32x32x16_bf16(pa0, (bf16x8){l0[0], l0[1], l0[2], l0[3], h0[0], h0[1], h0[2], h0[3]}, o[d0], 0, 0, 0); \
        o[d0] = __builtin_amdgcn_mfma_f32_32x32x16_bf16(pa1, (bf16x8){l1[0], l1[1], l1[2], l1[3], h1[0], h1[1], h1[2], h1[3]}, o[d0], 0, 0, 0); \
        o[d0] = __builtin_amdgcn_mfma_f32_32x32x16_bf16(pa2, (bf16x8){l2[0], l2[1], l2[2], l2[3], h2[0], h2[1], h2[2], h2[3]}, o[d0], 0, 0, 0); \
        o[d0] = __builtin_amdgcn_mfma_f32_32x32x16_bf16(pa3, (bf16x8){l3[0], l3[1], l3[2], l3[3], h3[0], h3[1], h3[2], h3[3]}, o[d0], 0, 0, 0); } while (0)
#define QK_TILE(P0, P1, KI, blk_, kb_) do { const int ko_ = (KI) * SHM_K, po_ = (KI) * SHM_KPE; \
        if constexpr (MODE == MLA) { P0 = f32x16{}; P1 = f32x16{}; } \
        else { const LAS float* btb = bt + (MODE == FOX ? (KI) * 64 : 0); \
            _Pragma("unroll") for (int gq = 0; gq < 4; ++gq) { const f32x4 b0 = *(const LAS f32x4*)(btb + 8 * gq), b1 = *(const LAS f32x4*)(btb + 32 + 8 * gq); \
                _Pragma("unroll") for (int j = 0; j < 4; ++j) { P0[4 * gq + j] = b0[j]; P1[4 * gq + j] = b1[j]; } } } \
        _Pragma("unroll") for (int d0 = 0; d0 < 8; ++d0) { const LAS unsigned char* ap = kb4[d0 & 3] + (d0 >> 2) * 128 + ko_; \
            const bf16x8 k0 = *(const LAS bf16x8*)ap, k1 = *(const LAS bf16x8*)(ap + 32 * 256); \
            P0 = __builtin_amdgcn_mfma_f32_32x32x16_bf16(k0, qr[d0], P0, 0, 0, 0); P1 = __builtin_amdgcn_mfma_f32_32x32x16_bf16(k1, qr[d0], P1, 0, 0, 0); } \
        if constexpr (MODE == MLA) { \
            _Pragma("unroll") for (int d0 = 0; d0 < 4; ++d0) { const LAS unsigned char* ap = pb4[d0] + po_; \
                const bf16x8 k0 = *(const LAS bf16x8*)ap, k1 = *(const LAS bf16x8*)(ap + 32 * 128); \
                P0 = __builtin_amdgcn_mfma_f32_32x32x16_bf16(k0, qr[8 + d0], P0, 0, 0, 0); P1 = __builtin_amdgcn_mfma_f32_32x32x16_bf16(k1, qr[8 + d0], P1, 0, 0, 0); } } \
        const float NEG = -__builtin_inff(); \
        if ((blk_) == qb && (kb_) + KVBLK - 1 > qlo) { const int dq = qpos - (kb_) - 4 * hi; \
            _Pragma("unroll") for (int r = 0; r < 16; ++r) { const int c = (r & 3) + 8 * (r >> 2); if (dq - c < 0) P0[r] = NEG; if (dq - c - 32 < 0) P1[r] = NEG; } } \
        if constexpr (MODE == MOBA) { if (((selmask >> (blk_)) & 1u) == 0u) { \
            _Pragma("unroll") for (int r = 0; r < 16; ++r) { P0[r] = NEG; P1[r] = NEG; } } } } while (0)
#define SM_PV(P0, P1, VI, kb_) do { \
        float aoff = 0.f; if constexpr (MODE == MOBA) aoff = sl2 * (float)((kb_) - qpos); \
        float pmax = P0[0]; \
        _Pragma("unroll") for (int r = 1; r < 16; ++r) pmax = fmaxf(pmax, P0[r]); \
        _Pragma("unroll") for (int r = 0; r < 16; ++r) pmax = fmaxf(pmax, P1[r]); \
        { auto rr = __builtin_amdgcn_permlane32_swap(__float_as_uint(pmax), __float_as_uint(pmax), false, false); pmax = fmaxf(__uint_as_float(rr[0]), __uint_as_float(rr[1])); } \
        pmax += aoff; \
        const bool dead_ = (MODE != MLA) && __all(pmax - m_reg < -150.f); \
        if (!dead_) { \
        float alpha = 1.f; \
        if (!__all(pmax - m_reg <= THRL)) { const float mn = fmaxf(m_reg, pmax); alpha = __builtin_amdgcn_exp2f(m_reg - mn); m_reg = mn; } \
        const float off = aoff - m_reg; \
        _Pragma("unroll") for (int r = 0; r < 16; ++r) { P0[r] = __builtin_amdgcn_exp2f(P0[r] + off); P1[r] = __builtin_amdgcn_exp2f(P1[r] + off); } \
        float ps = 0.f; \
        _Pragma("unroll") for (int r = 0; r < 16; ++r) ps += P0[r]; \
        _Pragma("unroll") for (int r = 0; r < 16; ++r) ps += P1[r]; \
        { auto rr = __builtin_amdgcn_permlane32_swap(__float_as_uint(ps), __float_as_uint(ps), false, false); ps = __uint_as_float(rr[0]) + __uint_as_float(rr[1]); } \
        l_reg = l_reg * alpha + ps; \
        bf16x8 pa0, pa1, pa2, pa3; \
        PK4(P0, 0, pa0); PK4(P0, 8, pa1); PK4(P1, 0, pa2); PK4(P1, 8, pa3); \
        if (__any(alpha < 1.f)) { if (hi == 0) al_l[r32] = alpha; LDS_WAIT(); \
            _Pragma("unroll") for (int d_ = 0; d_ < 4; ++d_) _Pragma("unroll") for (int r = 0; r < 16; ++r) o[d_][r] *= al_l[crow(r, hi)]; } \
        const int vb = vb0 + (VI) * SHM_V; \
        PV_D0(0); PV_D0(1); PV_D0(2); PV_D0(3); } } while (0)
#define T_NEXT(B_, S_, OK_) do { if (OK_) { if (--(S_) < 0) { (S_) = 3; const unsigned rest_ = need & ((1u << (B_)) - 1u); if (rest_ == 0u) (OK_) = false; else (B_) = 31 - __builtin_clz(rest_); } } } while (0)
#define STEP(PC0, PC1, PN0, PN1) do { \
        const int kb0 = b0 * 256 + s0 * 64, kb1 = b1 * 256 + s1 * 64; \
        const int ki1 = (ki == 2) ? 0 : ki + 1, ki2 = (ki1 == 2) ? 0 : ki1 + 1; \
        if (ok2) DMA_KT(b2 * 256 + s2 * 64, ki2); \
        if (ok1) DMA_VT(kb1, vi ^ 1); \
        SBAR(); \
        if constexpr (PIPE) { if (ok1) QK_TILE(PN0, PN1, ki1, b1, kb1); } else { QK_TILE(PC0, PC1, ki, b0, kb0); } \
        SM_PV(PC0, PC1, vi, kb0); \
        more = ok1; \
        if (more) { VM_WAIT(); __syncthreads(); b0 = b1; s0 = s1; b1 = b2; s1 = s2; ok1 = ok2; T_NEXT(b2, s2, ok2); ki = ki1; vi ^= 1; } } while (0)
    int b0 = 31 - __builtin_clz(need), s0 = 3; bool ok1 = true, ok2 = true, more = true;
    int b1 = b0, s1 = s0; T_NEXT(b1, s1, ok1);
    int b2 = b1, s2 = s1; ok2 = ok1; T_NEXT(b2, s2, ok2);
    DMA_KT(b0 * 256 + s0 * 64, 0); DMA_VT(b0 * 256 + s0 * 64, 0); if (ok1) DMA_KT(b1 * 256 + s1 * 64, 1);
    VM_WAIT(); __syncthreads();
    f32x16 pA0, pA1, pB0, pB1;
    int ki = 0, vi = 0;
    constexpr bool PIPE = (MODE != MLA);
    if constexpr (PIPE) QK_TILE(pA0, pA1, 0, b0, b0 * 256 + s0 * 64);
    for (;;) {
        STEP(pA0, pA1, pB0, pB1); if (!more) break;
        STEP(pB0, pB1, pA0, pA1); if (!more) break;
    }
#undef STEP
#undef T_NEXT
#undef SM_PV
#undef QK_TILE
#undef PV_D0
#undef TRRD
#undef PK4
#undef DMA_KT
#undef DMA_VT
    __syncthreads();
    if (hi == 0) li_l[r32] = l_reg; LDS_WAIT();
    LAS bf16_t* stg = (LAS bf16_t*)(lds + L_OST) + wid * 4096;
#pragma unroll
    for (int r = 0; r < 16; ++r) { const int orow = crow(r, hi); const float rl = __builtin_amdgcn_rcpf(li_l[orow]);
#pragma unroll
        for (int d0 = 0; d0 < 4; ++d0) { const float v = o[d0][r] * rl; const unsigned u = __float_as_uint(v); stg[orow * 128 + d0 * 32 + r32] = (bf16_t)((u + 0x7fffu + ((u >> 16) & 1u)) >> 16); } }
    LDS_WAIT();
    bf16_t* Og = a.o + (rowbase + q0 + wid * QBLK) * (size_t)NOATT + h * HD;
#pragma unroll
    for (int i = 0; i < 8; ++i) { const int row = i * 4 + (lane >> 4), ch = lane & 15; const u32x4 v = *(const LAS u32x4*)(stg + row * 128 + ch * 8); *(u32x4*)(Og + (size_t)row * NOATT + ch * 8) = v; }
    __syncthreads();
}
}

#define XB_TMO      128
#define XB_XCNT(j)  (256  + 64 * (j))
#define XB_XSUB(j)  (1280 + 64 * (j))
#define XB_XGEN(j)  (2304 + 64 * (j))
#define XB_TOP      3328
#define XB_TOPGEN   3392
#define XCD_BAR_WORDS 3456
#define XB_SPIN_CAP (1u << 22)
__device__ __forceinline__ unsigned xb_ld(unsigned* p)              { return __hip_atomic_load(p, __ATOMIC_RELAXED, __HIP_MEMORY_SCOPE_AGENT); }
__device__ __forceinline__ unsigned xb_add(unsigned* p, unsigned v) { return __hip_atomic_fetch_add(p, v, __ATOMIC_RELAXED, __HIP_MEMORY_SCOPE_AGENT); }
__device__ __forceinline__ unsigned xb_xcc_id() { return (unsigned)__builtin_amdgcn_s_getreg((3 << 11) | 20) & 0xFu; }
#define XB_SPIN(cond, bar) do { unsigned _sp = 0; while (cond) { __builtin_amdgcn_s_sleep(1); \
    if ((++_sp & 255u) == 0u) { if (xb_ld(&(bar)[XB_TMO])) break; if (_sp > XB_SPIN_CAP) { atomicAdd(&(bar)[XB_TMO], 1u); break; } } } } while (0)
struct XcdBarrier { unsigned* bar; unsigned x; volatile LAS unsigned* st; };
__device__ __forceinline__ XcdBarrier xcd_barrier_post(unsigned* bar, volatile LAS unsigned* st) {
    XcdBarrier b; b.bar = bar; b.x = xb_xcc_id(); b.st = st;
    if (threadIdx.x == 0) (void)xb_add(&bar[XB_XCNT(b.x)], 1u);
    return b;
}
__device__ __forceinline__ void xcd_barrier_complete(unsigned* bar, unsigned x, unsigned& nloc, unsigned& nx) {
    const unsigned G = gridDim.x * gridDim.y * gridDim.z;
    unsigned sum, cnt, mine, sp = 0u;
    for (;;) {
        sum = 0u; cnt = 0u; mine = 0u;
#pragma unroll
        for (unsigned j = 0; j < 16; ++j) { const unsigned c = xb_ld(&bar[XB_XCNT(j)]); sum += c; cnt += (c > 0u) ? 1u : 0u; mine = (j == x) ? c : mine; }
        if (sum == G) break;
        __builtin_amdgcn_s_sleep(1);
        if ((++sp & 255u) == 0u) { if (xb_ld(&bar[XB_TMO])) break; if (sp > XB_SPIN_CAP) { atomicAdd(&bar[XB_TMO], 1u); break; } }
    }
    nloc = mine > 0u ? mine : 1u; nx = cnt > 0u ? cnt : 1u;
}
__device__ __forceinline__ void xcd_barrier(const XcdBarrier& b, int tidx) {
    asm volatile("s_waitcnt vmcnt(0)" ::: "memory");
    __syncthreads();
    if (tidx == 0) {
        unsigned* bar = b.bar;
        __builtin_amdgcn_s_waitcnt(0);
        unsigned nloc = b.st[0], nx = b.st[1];
        if (nloc == 0u) { xcd_barrier_complete(bar, b.x, nloc, nx); b.st[0] = nloc; b.st[1] = nx; }
        const unsigned old = xb_add(&bar[XB_XSUB(b.x)], 1u);
        const unsigned gen = old / nloc;
        if (old + 1u == (gen + 1u) * nloc) {
            __builtin_amdgcn_fence(__ATOMIC_RELEASE, "agent");
            asm volatile("s_waitcnt vmcnt(0)" ::: "memory");
            const unsigned og = xb_add(&bar[XB_TOP], 1u);
            const unsigned tg = og / nx;
            if (og + 1u == (tg + 1u) * nx) xb_add(&bar[XB_TOPGEN], 1u);
            else XB_SPIN(xb_ld(&bar[XB_TOPGEN]) == tg, bar);
            __builtin_amdgcn_fence(__ATOMIC_ACQUIRE, "agent");
            xb_add(&bar[XB_XGEN(b.x)], 1u);
            asm volatile("s_waitcnt vmcnt(0)" ::: "memory");
        } else {
            XB_SPIN(xb_ld(&bar[XB_XGEN(b.x)]) == gen, bar);
            __builtin_amdgcn_fence(__ATOMIC_ACQUIRE, "agent");
            asm volatile("s_waitcnt vmcnt(0)" ::: "memory");
        }
    }
    __syncthreads();
}

struct KArgs {
    const float* x; const int* pos; const float* w_in; const float* b_forget; const float* g_q_a; const float* g_kv_a; const float* w_q_b; const float* w_kv_b;
    const float* w_br[3]; const float* w_o; const float* ln1_g; const float* ln1_b; const float* ln2_g; const float* ln2_b;
    const float* ffn_w1; const float* ffn_w3; const float* ffn_w2; const float* moe_router; const float* moe_w1; const float* moe_w3; const float* moe_w2;
    float* out; unsigned char* ws; int ph_lo, ph_hi;
};

__constant__ double ROPE_INV[32] = {1.0, 0.7498942093324559, 0.5623413251903491, 0.4216965034285822, 0.31622776601683794, 0.23713737056616552, 0.1778279410038923, 0.1333521432163324,
    0.09999999999999999, 0.07498942093324558, 0.056234132519034905, 0.042169650342858224, 0.03162277660168379, 0.023713737056616554, 0.01778279410038923, 0.013335214321633239,
    0.01, 0.007498942093324559, 0.005623413251903491, 0.004216965034285822, 0.0031622776601683794, 0.002371373705661655, 0.0017782794100389228, 0.0013335214321633238,
    0.001, 0.0007498942093324559, 0.000562341325190349, 0.00042169650342858224, 0.00031622776601683794, 0.00023713737056616554, 0.0001778279410038923, 0.0001333521432163324};

enum { MAP_ID = 0, MAP_WIN = 1, MAP_WQB = 2, MAP_WKVB = 3, MAP_GLU = 4, MAP_WING = 5 };
template <int MAPK>
__device__ __forceinline__ int src_col(int n, int& which) {
    which = 0;
    if constexpr (MAPK == MAP_ID) return n;
    if constexpr (MAPK == MAP_WIN) {
        if (n < C_CQ) return n;
        if (n < C_CKV) return SRC_CQ + (n - C_CQ);
        if (n < C_GATE) return SRC_CKV + (n - C_CKV);
        const int j = n - C_GATE;
        if (j < 64) { const int i = j >> 1; return SRC_KROPE + ((j & 1) ? 32 + i : i); }
        if (j < 72) return SRC_FORGET + (j - 64);
        return -1;
    }
    if constexpr (MAPK == MAP_WING) return SRC_GATE + n;
    if constexpr (MAPK == MAP_WQB) {
        if (n < 1024) { const int hh = n >> 7, d = n & 127; return hh * 192 + d; }
        const int j = n - 1024, hh = j >> 6, jj = j & 63, i = jj >> 1; return hh * 192 + 128 + ((jj & 1) ? 32 + i : i);
    }
    if constexpr (MAPK == MAP_WKVB) { const int hh = (n & 1023) >> 7, d = n & 127; return hh * 256 + (n >= 1024 ? 128 : 0) + d; }
    if constexpr (MAPK == MAP_GLU) { const int t = n >> 8, c = n & 255; which = (c >= 128) ? 1 : 0; return t * 128 + (c & 127); }
    return n;
}
template <int MAPK>
__device__ __forceinline__ void transpose_item(const float* W, const float* W2, const float* kscale, int K, int Nsrc, bf16_t* WT, LAS float* scr, int item, int nblk, int lane) {
    const int kb = item / nblk, nb = item % nblk, k0 = 64 * kb, n0 = 32 * nb;
    int which; const int scol = src_col<MAPK>(n0 + (lane & 31), which); const float* Ws = which ? W2 : W;
    const int scolc = scol >= 0 ? scol : 0; const float colm = scol >= 0 ? 1.f : 0.f;
    float v[32];
#pragma unroll
    for (int i = 0; i < 32; ++i) { const int kk = 2 * i + (lane >> 5); v[i] = Ws[(size_t)(k0 + kk) * Nsrc + scolc] * colm; }
#pragma unroll
    for (int i = 0; i < 32; ++i) { const int kk = 2 * i + (lane >> 5); float x = v[i]; if (kscale) x *= kscale[k0 + kk]; scr[kk * 33 + (lane & 31)] = x; }
    LDS_WAIT(); asm volatile("" ::: "memory");
    const int c = lane & 7;
#pragma unroll
    for (int j = 0; j < 4; ++j) { const int n = (lane >> 3) + 8 * j; const LAS float* s = scr + (8 * c) * 33 + n;
        u32x4 o; o.x = cvt_pk_bf16(s[0 * 33], s[1 * 33]); o.y = cvt_pk_bf16(s[2 * 33], s[3 * 33]); o.z = cvt_pk_bf16(s[4 * 33], s[5 * 33]); o.w = cvt_pk_bf16(s[6 * 33], s[7 * 33]);
        *(u32x4*)(WT + (size_t)(n0 + n) * K + k0 + 8 * c) = o; }
    LDS_WAIT(); asm volatile("" ::: "memory");
}
template <int MAPK>
__device__ __forceinline__ void transpose_item_f8(const float* W, const float* W2, float wscale, int K, int Nsrc, unsigned char* WT, LAS float* scr, int item, int nblk, int lane) {
    const int kb = item / nblk, nb = item % nblk, k0 = 64 * kb, n0 = 32 * nb;
    int which; const int scol = src_col<MAPK>(n0 + (lane & 31), which); const float* Ws = which ? W2 : W;
    const int scolc = scol >= 0 ? scol : 0; const float colm = scol >= 0 ? 1.f : 0.f;
    float v[32];
#pragma unroll
    for (int i = 0; i < 32; ++i) { const int kk = 2 * i + (lane >> 5); v[i] = Ws[(size_t)(k0 + kk) * Nsrc + scolc] * colm; }
#pragma unroll
    for (int i = 0; i < 32; ++i) { const int kk = 2 * i + (lane >> 5); scr[kk * 33 + (lane & 31)] = v[i] * wscale; }
    LDS_WAIT(); asm volatile("" ::: "memory");
    const int c = lane & 3;
#pragma unroll
    for (int j = 0; j < 2; ++j) { const int n = (lane >> 2) + 16 * j; const LAS float* sp = scr + (16 * c) * 33 + n;
        u32x4 o; o.x = pk4_fp8(sp[0 * 33], sp[1 * 33], sp[2 * 33], sp[3 * 33]); o.y = pk4_fp8(sp[4 * 33], sp[5 * 33], sp[6 * 33], sp[7 * 33]);
        o.z = pk4_fp8(sp[8 * 33], sp[9 * 33], sp[10 * 33], sp[11 * 33]); o.w = pk4_fp8(sp[12 * 33], sp[13 * 33], sp[14 * 33], sp[15 * 33]);
        *(u32x4*)(WT + (size_t)(n0 + n) * K + k0 + 16 * c) = o; }
    LDS_WAIT(); asm volatile("" ::: "memory");
}
template <int MAPK>
__device__ __forceinline__ void transpose_matrix_f8(const float* W, const float* W2, float wscale, int K, int Nsrc, int Ndst, unsigned char* WT, LAS float* scr, int gw, int NGW, int lane) {
    const int nblk = Ndst / 32, nitems = (K / 64) * nblk;
    for (int it = gw; it < nitems; it += NGW) transpose_item_f8<MAPK>(W, W2, wscale, K, Nsrc, WT, scr, it, nblk, lane);
}
template <int MAPK>
__device__ __forceinline__ void transpose_matrix(const float* W, const float* W2, const float* kscale, int K, int Nsrc, int Ndst, bf16_t* WT, LAS float* scr, int gw, int NGW, int lane) {
    const int nblk = Ndst / 32, nitems = (K / 64) * nblk;
    for (int it = gw; it < nitems; it += NGW) transpose_item<MAPK>(W, W2, kscale, K, Nsrc, WT, scr, it, nblk, lane);
}

#define LNC(j) (2 * (lane + 64 * ((j) >> 1)) + ((j) & 1))
__device__ __forceinline__ void ln_row(f32x4 (&v)[8], const float* g, const float* bta, int lane) {
    float s = 0.f;
#pragma unroll
    for (int j = 0; j < 8; ++j) s += (v[j][0] + v[j][1]) + (v[j][2] + v[j][3]);
    const float mean = wave_sum(s) * (1.f / DM); float s2 = 0.f;
#pragma unroll
    for (int j = 0; j < 8; ++j) { v[j] = v[j] - mean; s2 += (v[j][0] * v[j][0] + v[j][1] * v[j][1]) + (v[j][2] * v[j][2] + v[j][3] * v[j][3]); }
    const float rstd = 1.f / sqrtf(wave_sum(s2) * (1.f / DM) + LN_EPS);
#pragma unroll
    for (int j = 0; j < 8; ++j) { const f32x4 gg = *(const f32x4*)(g + 4 * LNC(j)), bb = *(const f32x4*)(bta + 4 * LNC(j)); v[j] = v[j] * rstd * gg + bb; }
}

__device__ __forceinline__ bool ph_in(int lo, int hi, int k) { asm volatile("" : "+s"(lo), "+s"(hi)); return lo <= k && k < hi; }
#define PHASE_PTRS() GAS unsigned char* ws0_ = (GAS unsigned char*)args.ws; asm volatile("" : "+s"(ws0_)); unsigned char* ws = (unsigned char*)ws0_;     \
    unsigned* ctl = (unsigned*)(ws + WS_CTL); (void)ctl; \
    int bx = blockIdx.x, G = gridDim.x; asm volatile("" : "+s"(bx), "+s"(G)); const int vcu = (G % 8 == 0) ? (bx % 8) * (G / 8) + bx / 8 : bx; const int NGW = G * NWAVES; (void)vcu; (void)NGW; \
    float* cosT = (float*)(ws + WS_COS); float* sinT = (float*)(ws + WS_SIN); float* ssq = (float*)(ws + WS_SSQ); float* lf = (float*)(ws + WS_LF); float* cb = (float*)(ws + WS_CB); \
    bf16_t* kmh = (bf16_t*)(ws + WS_KMH); bf16_t* kml = (bf16_t*)(ws + WS_KML); bf16_t* kpe = (bf16_t*)(ws + WS_KPE); \
    int* ltok = (int*)(ws + WS_LTOK); int* ldst = (int*)(ws + WS_LDST); float* lgate = (float*)(ws + WS_LGATE); \
    bf16_t* XB = (bf16_t*)(ws + WS_XB); bf16_t* X1 = (bf16_t*)(ws + WS_X1); bf16_t* PROJ = (bf16_t*)(ws + WS_PROJ); bf16_t* QM = (bf16_t*)(ws + WS_QM); bf16_t* KVM = (bf16_t*)(ws + WS_KVM); \
    bf16_t* OATT = (bf16_t*)(ws + WS_OATT); bf16_t* MERGED = (bf16_t*)(ws + WS_MERGED); bf16_t* Y = (bf16_t*)(ws + WS_Y); bf16_t* HID = (bf16_t*)(ws + WS_HID); bf16_t* YMOE = (bf16_t*)(ws + WS_YMOE); unsigned char* XGF = ws + WS_XGF; unsigned char* X1F = ws + WS_X1F; \
    (void)cosT; (void)sinT; (void)ssq; (void)lf; (void)cb; (void)kmh; (void)kml; (void)kpe; (void)ltok; (void)ldst; (void)lgate; (void)XB; (void)X1; (void)PROJ; (void)QM; (void)KVM; (void)OATT; (void)MERGED; (void)Y; (void)HID; (void)YMOE; (void)XGF; (void)X1F;
#define MOE_COUNTS() int cnt[8], tb[9]; tb[0] = 0; \
    _Pragma("unroll") for (int e = 0; e < 8; ++e) { cnt[e] = __builtin_amdgcn_readfirstlane((int)__hip_atomic_load(ctl + CW_CNT + e, RLX_AGENT)); if (cnt[e] > MTOK) cnt[e] = MTOK; tb[e + 1] = tb[e] + ((cnt[e] + 255) >> 8); }
#define OPAQUE_IDS() int tid = my_tid(wave0); const int lane = tid & 63, wave = __builtin_amdgcn_readfirstlane(tid >> 6); const int gw = vcu * NWAVES + wave; (void)lane; (void)gw;
constexpr int PH_PER_LAYER = 10, N_PHASES = 1 + 2 * PH_PER_LAYER;
#define IN(k) ph_in(lo, hi, (k))
#define SEAM(k) do { if (IN(k) && IN((k) + 1)) { XcdBarrier b_; b_.bar = (unsigned*)(args.ws + WS_CTL) + CW_BAR; b_.x = xb_xcc_id(); b_.st = MISC + 8; xcd_barrier(b_, my_tid(wave0)); } } while (0)
struct LArgs { const float* b_forget; const float* ln1_g; const float* ln1_b; const float* ln2_g; const float* ln2_b; const float* moe_router; float* out; unsigned char* ws; };
template <int l>
__device__ __forceinline__ void layer_fn(const LArgs args, LAS unsigned char* ldsL, volatile LAS unsigned* MISC, const int wave0, const int lo, const int hi) {
        const int P = 1 + l * PH_PER_LAYER;
        for (int rep_ = 0; rep_ < NREP(0); ++rep_) if (IN(P + 0) && EN(0)) {
            PHASE_PTRS();
            pg8::Shape g{DM, DM, DM};
            SchedPlain S{64, 29, G, bx, (unsigned)WS_XB, (unsigned)(WS_WIN + (size_t)l * NWIN16 * DM * 2), 256u * DM * 2, 256u * DM * 2};
            EpiInProj E{PROJ, ssq, cosT, sinT, kpe, lf, args.b_forget + l * 8};
            pg8::gemm_phase(ldsL, (const char*)ws, wave0, g, S, E);
            pg8::Shape g8{DM / 2, DM / 2, DM / 2};
            SchedGates S8{G, bx, (unsigned)WS_XBF, (unsigned)(WS_WINF + (size_t)l * 6144 * DM)};
            EpiGates8 E8{PROJ};
            pg8::gemm_phase<EpiGates8, SchedGates, true>(ldsL, (const char*)ws, wave0, g8, S8, E8);
        }
        SEAM(P + 0);
        for (int rep_ = 0; rep_ < NREP(1); ++rep_) if (IN(P + 1) && EN(1)) {
            PHASE_PTRS();
            { OPAQUE_IDS();
            if (gw < 32) {
                const int b = gw >> 3, h = gw & 7; float carry = 0.f;
                for (int j = 0; j < 64; ++j) { const int s = j * 64 + lane; float v = lf[((size_t)b * SEQ + s) * 8 + h];
#pragma unroll
                    for (int o = 1; o < 64; o <<= 1) { const float t = __int_as_float(__builtin_amdgcn_ds_bpermute(((lane - o) & 63) << 2, __float_as_int(v))); if (lane >= o) v += t; }
                    cb[(size_t)gw * SEQ + s] = -(carry + v) * LOG2E; carry += __int_as_float(__builtin_amdgcn_readlane(__float_as_int(v), 63)); }
            } else if (gw < 32 + 512) {
                const int it = gw - 32, bh = it >> 4, n = it & 15, b = bh >> 3, h = bh & 7;
                const bf16_t* kp = PROJ + ((size_t)b * SEQ + n * 256) * NPROJ + C_MOBA + 1024 + h * HD + 2 * lane; float s0 = 0.f, s1 = 0.f;
#pragma unroll 16
                for (int r = 0; r < 256; ++r) { const unsigned w = *(const unsigned*)(kp + (size_t)r * NPROJ); s0 += bf_lo(w); s1 += bf_hi(w); }
                s0 *= (1.f / 256.f); s1 *= (1.f / 256.f);
                const unsigned hw = cvt_pk_bf16(s0, s1); const unsigned lw = cvt_pk_bf16(s0 - bf_lo(hw), s1 - bf_hi(hw));
                *(unsigned*)(kmh + (size_t)it * HD + 2 * lane) = hw; *(unsigned*)(kml + (size_t)it * HD + 2 * lane) = lw;
            } }
            __syncthreads();
            pg8::Shape g{QLORA, NPROJ, QLORA};
            SchedMlaUp S{G, bx, (unsigned)(WS_PROJ + C_CQ * 2), (unsigned)(WS_PROJ + C_CKV * 2), (unsigned)(WS_WQB + (size_t)l * NQM * QLORA * 2), (unsigned)(WS_WKVB + (size_t)l * NKVM * QLORA * 2)};
            EpiMlaUp E{QM, KVM, ssq, cosT, sinT};
            pg8::gemm_phase(ldsL, (const char*)ws, wave0, g, S, E);
        }
        SEAM(P + 1);
        for (int rep_ = 0; rep_ < NREP(2); ++rep_) if (IN(P + 2) && EN(2)) {
            PHASE_PTRS();
            for (int it = vcu; it < 256; it += G) { const int bh = it >> 3, s = it & 7, b = bh >> 3, h = bh & 7;
                if (ATT_MODES & 1) { att::Args a{PROJ + C_MOBA, NPROJ, nullptr, PROJ + C_MOBA + 1024, NPROJ, nullptr, PROJ + C_MOBA + 2048, NPROJ, OATT, nullptr, kmh, kml};
                  for (int ps = 0; ps < 2; ++ps) att::attn_unit<att::MOBA>(a, b, h, ps ? 15 - s : s, ldsL, wave0); }
                if (ATT_MODES & 2) { att::Args a{PROJ + C_FOX, NPROJ, nullptr, PROJ + C_FOX + 1024, NPROJ, nullptr, PROJ + C_FOX + 2048, NPROJ, OATT + 1024, cb, nullptr, nullptr};
                  for (int ps = 0; ps < 2; ++ps) att::attn_unit<att::FOX>(a, b, h, ps ? 15 - s : s, ldsL, wave0); }
                if (ATT_MODES & 4) { att::Args a{QM, NQM, QM + 1024, KVM, NKVM, kpe, KVM + 1024, NKVM, OATT + 2048, nullptr, nullptr, nullptr};
                  for (int ps = 0; ps < 2; ++ps) att::attn_unit<att::MLA>(a, b, h, ps ? 15 - s : s, ldsL, wave0); }
            }
        }
        SEAM(P + 2);
        for (int rep_ = 0; rep_ < NREP(3); ++rep_) if (IN(P + 3) && EN(3)) {
            PHASE_PTRS();
            pg8::Shape g{1024, NOATT, 1024};
            SchedMerge S{G, bx, (unsigned)WS_OATT, (unsigned)(WS_WBR + (size_t)l * 3 * DM * 1024 * 2)};
            EpiGateMerge E{PROJ, MERGED};
            pg8::gemm_phase(ldsL, (const char*)ws, wave0, g, S, E);
        }
        SEAM(P + 3);
        for (int rep_ = 0; rep_ < NREP(4); ++rep_) if (IN(P + 4) && EN(4)) {
            PHASE_PTRS();
            pg8::Shape g{DM, DM, DM};
            SchedPlain S{64, 8, G, bx, (unsigned)WS_MERGED, (unsigned)(WS_WO + (size_t)l * DM * DM * 2), 256u * DM * 2, 256u * DM * 2};
            EpiResidual E{XB, Y};
            pg8::gemm_phase(ldsL, (const char*)ws, wave0, g, S, E);
        }
        SEAM(P + 4);
        if (IN(P + 5) && EN(5)) {
            PHASE_PTRS(); OPAQUE_IDS();
            const float* g1 = args.ln1_g + l * DM; const float* b1 = args.ln1_b + l * DM;
            if (l == 0) {
                for (int m = gw; m < MTOK; m += NGW) { f32x4 v[8]; const u32x4* yr = (const u32x4*)(Y + (size_t)m * DM);
#pragma unroll
                    for (int jj = 0; jj < 4; ++jj) unpack8(yr[lane + 64 * jj], v[2 * jj], v[2 * jj + 1]);
                    ln_row(v, g1, b1, lane); u32x4* o16 = (u32x4*)(X1 + (size_t)m * DM);
#pragma unroll
                    for (int jj = 0; jj < 4; ++jj) o16[lane + 64 * jj] = pack8(v[2 * jj], v[2 * jj + 1]); }
            } else {
                LAS float* wrT = (LAS float*)ldsL; LAS int* selE = (LAS int*)(ldsL + 65536); LAS float* selG = (LAS float*)(ldsL + 65536 + 1024); LAS int* baseE = (LAS int*)(ldsL + 65536 + 2048);
                for (int u = tid; u < DM * NEXP; u += NWAVES * 64) { const int d = u >> 3, e = u & 7; wrT[e * DM + d] = args.moe_router[u]; }
                __syncthreads();
                for (int c0 = vcu * 64; c0 < MTOK; c0 += G * 64) {
                    for (int i = 0; i < 8; ++i) { const int tl = wave * 8 + i, m = c0 + tl; f32x4 v[8]; const u32x4* yr = (const u32x4*)(Y + (size_t)m * DM);
#pragma unroll
                        for (int jj = 0; jj < 4; ++jj) unpack8(yr[lane + 64 * jj], v[2 * jj], v[2 * jj + 1]);
                        ln_row(v, g1, b1, lane); u32x4* o16 = (u32x4*)(X1 + (size_t)m * DM);
#pragma unroll
                        for (int jj = 0; jj < 4; ++jj) o16[lane + 64 * jj] = pack8(v[2 * jj], v[2 * jj + 1]);
                        { u32x2* o8 = (u32x2*)(X1F + (size_t)m * DM);
#pragma unroll
                          for (int jj = 0; jj < 4; ++jj) { u32x2 w; w.x = pk4_fp8(v[2 * jj][0] * X_SCALE, v[2 * jj][1] * X_SCALE, v[2 * jj][2] * X_SCALE, v[2 * jj][3] * X_SCALE);
                              w.y = pk4_fp8(v[2 * jj + 1][0] * X_SCALE, v[2 * jj + 1][1] * X_SCALE, v[2 * jj + 1][2] * X_SCALE, v[2 * jj + 1][3] * X_SCALE); o8[lane + 64 * jj] = w; } }
                        float lg[8];
#pragma unroll
                        for (int e = 0; e < 8; ++e) { float s = 0.f;
#pragma unroll
                            for (int j = 0; j < 8; ++j) { const f32x4 w = *(const LAS f32x4*)(wrT + e * DM + 4 * LNC(j)); s += (v[j][0] * w[0] + v[j][1] * w[1]) + (v[j][2] * w[2] + v[j][3] * w[3]); }
                            lg[e] = wave_sum(s); }
                        int e0 = 0; float v0 = lg[0];
#pragma unroll
                        for (int e = 1; e < 8; ++e) if (lg[e] > v0) { v0 = lg[e]; e0 = e; }
                        int e1 = -1; float v1 = -__builtin_inff();
#pragma unroll
                        for (int e = 0; e < 8; ++e) if (e != e0 && lg[e] > v1) { v1 = lg[e]; e1 = e; }
                        const float g0 = 1.0f / (1.0f + expf(v1 - v0));
                        if (lane == 0) { selE[tl * 2] = e0; selE[tl * 2 + 1] = e1; selG[tl * 2] = g0; selG[tl * 2 + 1] = 1.0f - g0; } }
                    __syncthreads();
                    if (wave == 0) { const int e0 = selE[lane * 2], e1 = selE[lane * 2 + 1]; int r0 = 0, r1 = 0, mycnt = 0;
                        const unsigned long long lt = (1ull << lane) - 1ull;
#pragma unroll
                        for (int e = 0; e < 8; ++e) { const unsigned long long m0 = __ballot(e0 == e), m1 = __ballot(e1 == e); const int c0e = __popcll(m0);
                            if (e0 == e) r0 = __popcll(m0 & lt); if (e1 == e) r1 = c0e + __popcll(m1 & lt); if (lane == e) mycnt = c0e + __popcll(m1); }
                        int mybase = 0; if (lane < 8) mybase = (int)atomicAdd(ctl + CW_CNT + lane, (unsigned)mycnt);
                        const int b0 = __builtin_amdgcn_ds_bpermute(e0 << 2, mybase), b1 = __builtin_amdgcn_ds_bpermute(e1 << 2, mybase); const int m = c0 + lane;
                        const int p0 = b0 + r0, p1 = b1 + r1;
                        ltok[e0 * MTOK + p0] = m; ldst[e0 * MTOK + p0] = 2 * m; lgate[e0 * MTOK + p0] = selG[lane * 2];
                        ltok[e1 * MTOK + p1] = m; ldst[e1 * MTOK + p1] = 2 * m + 1; lgate[e1 * MTOK + p1] = selG[lane * 2 + 1]; }
                    __syncthreads();
                }
            }
        }
        SEAM(P + 5);
        if (IN(P + 6) && EN(6) && l == 1) {
            PHASE_PTRS(); OPAQUE_IDS(); MOE_COUNTS();
            const int nrows = tb[8] * 256;
            for (int r = gw; r < nrows; r += NGW) { const int t = r >> 8; int e = 0;
#pragma unroll
                for (int j = 1; j < 8; ++j) e += (t >= tb[j]) ? 1 : 0;
                int tbe = 0, ce = 0;
#pragma unroll
                for (int j = 0; j < 8; ++j) if (j == e) { tbe = tb[j]; ce = cnt[j]; }
                const int pos = r - tbe * 256; const int tok = (pos < ce) ? __builtin_amdgcn_readfirstlane((int)__hip_atomic_load((unsigned*)ltok + e * MTOK + pos, RLX_AGENT)) : MTOK;
                const u32x4* src = (const u32x4*)(X1F + (size_t)tok * DM); u32x4* dst = (u32x4*)(XGF + (size_t)r * DM);
#pragma unroll
                for (int j = 0; j < 2; ++j) dst[lane + 64 * j] = src[lane + 64 * j]; }
        }
        if (l == 1) SEAM(P + 6);
        for (int rep_ = 0; rep_ < NREP(7); ++rep_) if (IN(P + 7) && EN(7)) {
            PHASE_PTRS();
            if (l == 0) {
                pg8::Shape g{DM, DM, DM};
                SchedPlain S{64, 2 * DFF / 256, G, bx, (unsigned)WS_X1, (unsigned)WS_WF13, 256u * DM * 2, 256u * DM * 2};
                EpiSwiGLU E{HID, DFF};
                pg8::gemm_phase(ldsL, (const char*)ws, wave0, g, S, E);
            } else {
                MOE_COUNTS();
                pg8::Shape g{DM / 2, DM / 2, DM / 2};
                SchedMoe S; S.nM = tb[8]; S.nN = 2 * DFFE / 256; S.G = G; S.c = bx; S.A = (unsigned)WS_XGF; S.B = (unsigned)WS_WM13; S.tA = 256u * DM; S.tB = 256u * DM; S.eB = 2u * DFFE * DM;
                S.tbp = (unsigned long long)((unsigned)tb[1] | ((unsigned)tb[2] << 8) | ((unsigned)tb[3] << 16) | ((unsigned)tb[4] << 24)) | ((unsigned long long)((unsigned)tb[5] | ((unsigned)tb[6] << 8) | ((unsigned)tb[7] << 16) | ((unsigned)tb[8] << 24)) << 32);
                EpiSwiGLU8 E{(unsigned char*)HID, DFFE};
                pg8::gemm_phase<EpiSwiGLU8, SchedMoe, true>(ldsL, (const char*)ws, wave0, g, S, E);
            }
        }
        SEAM(P + 7);
        for (int rep_ = 0; rep_ < NREP(8); ++rep_) if (IN(P + 8) && EN(8)) {
            PHASE_PTRS();
            if (l == 0) {
                pg8::Shape g{DFF, DFF, DFF};
                SchedPlain S{64, 8, G, bx, (unsigned)WS_HID, (unsigned)WS_WF2, 256u * DFF * 2, 256u * DFF * 2};
                EpiResidual E{X1, Y};
                pg8::gemm_phase(ldsL, (const char*)ws, wave0, g, S, E);
            } else {
                MOE_COUNTS();
                pg8::Shape g{DFFE / 2, DFFE / 2, DFFE / 2};
                SchedMoe S; S.nM = tb[8]; S.nN = 8; S.G = G; S.c = bx; S.A = (unsigned)WS_HID; S.B = (unsigned)WS_WM2; S.tA = 256u * DFFE; S.tB = 256u * DFFE; S.eB = (unsigned)DM * DFFE;
                S.tbp = (unsigned long long)((unsigned)tb[1] | ((unsigned)tb[2] << 8) | ((unsigned)tb[3] << 16) | ((unsigned)tb[4] << 24)) | ((unsigned long long)((unsigned)tb[5] | ((unsigned)tb[6] << 8) | ((unsigned)tb[7] << 16) | ((unsigned)tb[8] << 24)) << 32);
                EpiMoeDown E; E.ymoe = YMOE; E.ldst = ldst; E.lgate = lgate;
                E.tbp = (unsigned long long)((unsigned)tb[0] | ((unsigned)tb[1] << 8) | ((unsigned)tb[2] << 16) | ((unsigned)tb[3] << 24)) | ((unsigned long long)((unsigned)tb[4] | ((unsigned)tb[5] << 8) | ((unsigned)tb[6] << 16) | ((unsigned)tb[7] << 24)) << 32);
                E.cntp = ctl + CW_CNT;
                pg8::gemm_phase<EpiMoeDown, SchedMoe, true>(ldsL, (const char*)ws, wave0, g, S, E);
            }
        }
        SEAM(P + 8);
        for (int rep_ = 0; rep_ < NREP(9); ++rep_) if (IN(P + 9) && EN(9)) {
            PHASE_PTRS(); OPAQUE_IDS();
            const float* g2 = args.ln2_g + l * DM; const float* b2 = args.ln2_b + l * DM;
            for (int m = gw; m < MTOK; m += NGW) { f32x4 v[8];
                if (l == 0) { const u32x4* yr = (const u32x4*)(Y + (size_t)m * DM);
#pragma unroll
                    for (int jj = 0; jj < 4; ++jj) unpack8(yr[lane + 64 * jj], v[2 * jj], v[2 * jj + 1]);
                } else { const u32x4* xr = (const u32x4*)(X1 + (size_t)m * DM); const u32x4* y0 = (const u32x4*)(YMOE + (size_t)(2 * m) * DM); const u32x4* y1 = (const u32x4*)(YMOE + (size_t)(2 * m + 1) * DM);
#pragma unroll
                    for (int jj = 0; jj < 4; ++jj) { f32x4 a0, a1, p0, p1, q0, q1; unpack8(xr[lane + 64 * jj], a0, a1); unpack8(y0[lane + 64 * jj], p0, p1); unpack8(y1[lane + 64 * jj], q0, q1);
                        v[2 * jj] = a0 * ALPHA + p0 + q0; v[2 * jj + 1] = a1 * ALPHA + p1 + q1; } }
                ln_row(v, g2, b2, lane);
                if (l == 0) { u32x4* o16 = (u32x4*)(XB + (size_t)m * DM); u32x2* o8 = (u32x2*)(ws + WS_XBF + (size_t)m * DM);
#pragma unroll
                    for (int jj = 0; jj < 4; ++jj) { o16[lane + 64 * jj] = pack8(v[2 * jj], v[2 * jj + 1]);
                        u32x2 w; w.x = pk4_fp8(v[2 * jj][0] * X_SCALE, v[2 * jj][1] * X_SCALE, v[2 * jj][2] * X_SCALE, v[2 * jj][3] * X_SCALE);
                        w.y = pk4_fp8(v[2 * jj + 1][0] * X_SCALE, v[2 * jj + 1][1] * X_SCALE, v[2 * jj + 1][2] * X_SCALE, v[2 * jj + 1][3] * X_SCALE); o8[lane + 64 * jj] = w; }
                } else { f32x4* o = (f32x4*)(args.out + (size_t)m * DM);
#pragma unroll
                    for (int j = 0; j < 8; ++j) o[LNC(j)] = v[j]; } }
        }
        if (l == 0) SEAM(P + 9);
        }

__global__ void __launch_bounds__(NWAVES * 64, 2) hyb_fwd(KArgs args) {
    extern __shared__ __attribute__((aligned(16))) unsigned char lds[];
    LAS unsigned char* ldsL = (LAS unsigned char*)lds;
    volatile LAS unsigned* MISC = (volatile LAS unsigned*)(ldsL + MISC_OFF);
    const int tid0 = threadIdx.x; const int wave0 = __builtin_amdgcn_readfirstlane(tid0 >> 6);
    unsigned char* ws = args.ws;
    unsigned* ctl = (unsigned*)(ws + WS_CTL);
    for (int u = tid0; u < (LDS_BYTES - RING_BYTES) / 4; u += NWAVES * 64) ((LAS unsigned*)(ldsL + RING_BYTES))[u] = 0u;
    __syncthreads();
    if (MK_N_LAUNCHES == 1) (void)xcd_barrier_post(ctl + CW_BAR, MISC + 8);
    const int lo = args.ph_lo, hi = args.ph_hi;
    for (int rep_ = 0; rep_ < NREP(10); ++rep_) if (IN(0) && EN(10)) {
        PHASE_PTRS(); OPAQUE_IDS();
        LAS float* scr = (LAS float*)(ldsL + wave * 16384);
        for (int l = 0; l < 2; ++l) {
            transpose_matrix<MAP_WIN>(args.w_in + (size_t)l * DM * SRC_NPROJ, nullptr, nullptr, DM, SRC_NPROJ, NWIN16, (bf16_t*)(ws + WS_WIN) + (size_t)l * NWIN16 * DM, scr, gw, NGW, lane);
            transpose_matrix_f8<MAP_WING>(args.w_in + (size_t)l * DM * SRC_NPROJ, nullptr, W13_SCALE, DM, SRC_NPROJ, 6144, ws + WS_WINF + (size_t)l * 6144 * DM, scr, gw, NGW, lane);
            transpose_matrix<MAP_WQB>(args.w_q_b + (size_t)l * QLORA * NQM, nullptr, args.g_q_a + l * QLORA, QLORA, NQM, NQM, (bf16_t*)(ws + WS_WQB) + (size_t)l * NQM * QLORA, scr, gw, NGW, lane);
            transpose_matrix<MAP_WKVB>(args.w_kv_b + (size_t)l * QLORA * NKVM, nullptr, args.g_kv_a + l * QLORA, QLORA, NKVM, NKVM, (bf16_t*)(ws + WS_WKVB) + (size_t)l * NKVM * QLORA, scr, gw, NGW, lane);
            for (int br = 0; br < 3; ++br)
                transpose_matrix<MAP_ID>(args.w_br[br] + (size_t)l * 1024 * DM, nullptr, nullptr, 1024, DM, DM, (bf16_t*)(ws + WS_WBR) + ((size_t)l * 3 + br) * DM * 1024, scr, gw, NGW, lane);
            transpose_matrix<MAP_ID>(args.w_o + (size_t)l * DM * DM, nullptr, nullptr, DM, DM, DM, (bf16_t*)(ws + WS_WO) + (size_t)l * DM * DM, scr, gw, NGW, lane);
        }
        transpose_matrix<MAP_GLU>(args.ffn_w1, args.ffn_w3, nullptr, DM, DFF, 2 * DFF, (bf16_t*)(ws + WS_WF13), scr, gw, NGW, lane);
        transpose_matrix<MAP_ID>(args.ffn_w2, nullptr, nullptr, DFF, DM, DM, (bf16_t*)(ws + WS_WF2), scr, gw, NGW, lane);
        for (int e = 0; e < NEXP; ++e) {
            transpose_matrix_f8<MAP_GLU>(args.moe_w1 + (size_t)e * DM * DFFE, args.moe_w3 + (size_t)e * DM * DFFE, W13_SCALE, DM, DFFE, 2 * DFFE, ws + WS_WM13 + (size_t)e * 2 * DFFE * DM, scr, gw, NGW, lane);
            transpose_matrix_f8<MAP_ID>(args.moe_w2 + (size_t)e * DFFE * DM, nullptr, W2_SCALE, DFFE, DM, DM, ws + WS_WM2 + (size_t)e * DM * DFFE, scr, gw, NGW, lane);
        }
        for (int m = gw; m < MTOK; m += NGW) { const f32x4* xr = (const f32x4*)(args.x + (size_t)m * DM); u32x2* o8 = (u32x2*)(XB + (size_t)m * DM);
#pragma unroll
            for (int j = 0; j < 8; ++j) { const f32x4 v = xr[lane + 64 * j]; u32x2 w; w.x = cvt_pk_bf16(v[0], v[1]); w.y = cvt_pk_bf16(v[2], v[3]); o8[lane + 64 * j] = w;
                ((unsigned*)(ws + WS_XBF + (size_t)m * DM))[lane + 64 * j] = pk4_fp8(v[0] * X_SCALE, v[1] * X_SCALE, v[2] * X_SCALE, v[3] * X_SCALE); } }
        for (int idx = bx * (NWAVES * 64) + tid; idx < MTOK * 32; idx += G * NWAVES * 64) { const int m = idx >> 5, i = idx & 31;
            const double ang = (double)args.pos[m] * ROPE_INV[i]; const double t = ang * 0.15915494309189535; const double fr = t - floor(t);
            const double x4 = fr * 4.0; const int oct = (int)x4; const double r = (x4 - (double)oct) * 1.5707963267948966;
            const double rr = r - 0.7853981633974483, r2 = rr * rr;
            double sn = rr * (1.0 + r2 * (-1.0 / 6 + r2 * (1.0 / 120 + r2 * (-1.0 / 5040 + r2 * (1.0 / 362880 + r2 * (-1.0 / 39916800 + r2 * (1.0 / 6227020800.0)))))));
            double cs = 1.0 + r2 * (-0.5 + r2 * (1.0 / 24 + r2 * (-1.0 / 720 + r2 * (1.0 / 40320 + r2 * (-1.0 / 3628800 + r2 * (1.0 / 479001600.0 + r2 * (-1.0 / 87178291200.0)))))));
            const double h = 0.7071067811865476; const double s1 = h * (sn + cs), c1 = h * (cs - sn);
            double so, co; if (oct == 0) { so = s1; co = c1; } else if (oct == 1) { so = c1; co = -s1; } else if (oct == 2) { so = -s1; co = -c1; } else { so = -c1; co = s1; }
            cosT[idx] = (float)co; sinT[idx] = (float)so; }
        if (bx == 0) { for (int u = tid; u < DM / 2; u += NWAVES * 64) { ((unsigned*)(XB + (size_t)MTOK * DM))[u] = 0u; ((unsigned*)(X1 + (size_t)MTOK * DM))[u] = 0u; ((unsigned*)(X1F + (size_t)MTOK * DM))[u & 511] = 0u; } }
    }
    SEAM(0);

    const LArgs la{args.b_forget, args.ln1_g, args.ln1_b, args.ln2_g, args.ln2_b, args.moe_router, args.out, args.ws};
    layer_fn<0>(la, ldsL, MISC, wave0, lo, hi);
    layer_fn<1>(la, ldsL, MISC, wave0, lo, hi);
#undef IN
#undef SEAM
}

extern "C" void kernel_launch(void* const* d_in, const int* in_sizes, int n_in, void* d_out, int out_size, void* d_ws, size_t ws_size, hipStream_t stream) {
    static int grid = 0;
    if (grid == 0) {
        if (n_in != 23 || ws_size < WS_END) { fprintf(stderr, "kernel_launch: need 23 inputs and >= %zu bytes of workspace; got %d, %zu\n", (size_t)WS_END, n_in, ws_size); grid = -1; return; }
        int dev = 0, cus = 0;
        if (hipGetDevice(&dev) != hipSuccess || hipDeviceGetAttribute(&cus, hipDeviceAttributeMultiprocessorCount, dev) != hipSuccess) { grid = -1; return; }
        if (hipFuncSetAttribute((const void*)hyb_fwd, hipFuncAttributeMaxDynamicSharedMemorySize, LDS_BYTES) != hipSuccess) { fprintf(stderr, "kernel_launch: hipFuncSetAttribute failed\n"); grid = -1; return; }
        int per_cu = 0;
        if (hipOccupancyMaxActiveBlocksPerMultiprocessor(&per_cu, (const void*)hyb_fwd, NWAVES * 64, LDS_BYTES) != hipSuccess || per_cu < 1) { fprintf(stderr, "kernel_launch: occupancy query says %d\n", per_cu); }
        (void)hipGetLastError();
        grid = cus;
    }
    if (grid < 0) return;
    (void)hipMemsetAsync((char*)d_ws + WS_CTL, 0, CTL_ZERO_BYTES, stream);
    KArgs a{};
    a.x = (const float*)d_in[0]; a.pos = (const int*)d_in[1]; a.w_in = (const float*)d_in[2]; a.b_forget = (const float*)d_in[3]; a.g_q_a = (const float*)d_in[4]; a.g_kv_a = (const float*)d_in[5];
    a.w_q_b = (const float*)d_in[6]; a.w_kv_b = (const float*)d_in[7]; a.w_br[0] = (const float*)d_in[8]; a.w_br[1] = (const float*)d_in[9]; a.w_br[2] = (const float*)d_in[10]; a.w_o = (const float*)d_in[11];
    a.ln1_g = (const float*)d_in[12]; a.ln1_b = (const float*)d_in[13]; a.ln2_g = (const float*)d_in[14]; a.ln2_b = (const float*)d_in[15];
    a.ffn_w1 = (const float*)d_in[16]; a.ffn_w3 = (const float*)d_in[17]; a.ffn_w2 = (const float*)d_in[18]; a.moe_router = (const float*)d_in[19]; a.moe_w1 = (const float*)d_in[20]; a.moe_w3 = (const float*)d_in[21]; a.moe_w2 = (const float*)d_in[22];
    a.out = (float*)d_out; a.ws = (unsigned char*)d_ws;
#if MK_N_LAUNCHES == 1
    a.ph_lo = 0; a.ph_hi = N_PHASES;
    hipLaunchKernelGGL(hyb_fwd, dim3(grid), dim3(NWAVES * 64), LDS_BYTES, stream, a);
#else
    for (int p = 0; p < N_PHASES; ++p) { if (p == 7) continue; a.ph_lo = p; a.ph_hi = p + 1; hipLaunchKernelGGL(hyb_fwd, dim3(grid), dim3(NWAVES * 64), LDS_BYTES, stream, a); }
#endif
}
```

```cpp
#include <hip/hip_runtime.h>
#include <cstdio>
#include <cstdint>
#include <type_traits>

#ifndef MK_N_LAUNCHES
#define MK_N_LAUNCHES 1
#endif
#ifndef PH_ENABLE
#define PH_ENABLE 0xFFFF
#endif
#define EN(k) (((PH_ENABLE) >> (k)) & 1)
#ifndef PROBE_REPEAT
#define PROBE_REPEAT 0
#endif
#define NREP(k) ((((PROBE_REPEAT) >> (k)) & 1) ? 2 : 1)
#ifndef ATT_MODES
#define ATT_MODES 7
#endif

#define GAS __attribute__((address_space(1)))
#define LAS __attribute__((address_space(3)))
typedef unsigned short bf16_t;
typedef short bf16x8 __attribute__((ext_vector_type(8)));
typedef short s16x4 __attribute__((ext_vector_type(4)));
typedef float f32x4 __attribute__((ext_vector_type(4)));
typedef float f32x2 __attribute__((ext_vector_type(2)));
typedef float f32x16 __attribute__((ext_vector_type(16)));
typedef unsigned u32x4 __attribute__((ext_vector_type(4)));
typedef unsigned u32x2 __attribute__((ext_vector_type(2)));

constexpr int NBATCH = 4, SEQ = 4096, DM = 2048, MTOK = NBATCH * SEQ, NHEAD = 8, HD = 128;
constexpr int NPROJ = 13568;
constexpr int C_MOBA = 0, C_FOX = 3072, C_CQ = 6144, C_CKV = 6656, C_GATE = 7168, C_SPEC = 13312;
constexpr int SRC_FORGET = 6144, SRC_CQ = 6152, SRC_CKV = 6664, SRC_KROPE = 7176, SRC_GATE = 7240, SRC_NPROJ = 13384;
constexpr int QLORA = 512, NQM = 1536, NKVM = 2048;
constexpr int DFF = 5632, DFFE = 7168, NEXP = 8;
constexpr int NOATT = 3072;
constexpr float ALPHA = 1.4142135623730951f;
constexpr float LN_EPS = 1e-5f, RMS_EPS = 1e-6f;
constexpr float LOG2E = 1.4426950408889634f;
constexpr float C2_128 = 0.12751743082459868f;
constexpr float C2_192 = 0.10411754627697264f;
constexpr float W13_SCALE = 256.f, W2_SCALE = 1024.f, X_SCALE = 8.f, H_SCALE = 4.f;
constexpr int MOE_MAXT = 136;

constexpr size_t MiB = 1u << 20;
constexpr size_t WS_CTL = 0, CTL_ZERO_BYTES = 1 * MiB;
constexpr size_t WS_COS = 1 * MiB, WS_SIN = 3 * MiB;
constexpr size_t WS_SSQ = 5 * MiB;
constexpr size_t WS_LF = 6 * MiB;
constexpr size_t WS_CB = 6 * MiB + 512 * 1024;
constexpr size_t WS_KMH = 7 * MiB, WS_KML = 7 * MiB + 128 * 1024;
constexpr size_t WS_LTOK = 8 * MiB, WS_LDST = 8 * MiB + 512 * 1024, WS_LGATE = 9 * MiB;
constexpr size_t WS_KPE = 10 * MiB;
constexpr size_t WS_WQB = 16 * MiB;
constexpr size_t WS_WKVB = 19 * MiB;
constexpr size_t WS_WBR = 23 * MiB;
constexpr size_t WS_WO = 47 * MiB;
constexpr size_t WS_WIN = 63 * MiB;
constexpr size_t WS_WF13 = 169 * MiB;
constexpr size_t WS_WF2 = 213 * MiB;
constexpr size_t WS_WM13 = 235 * MiB;
constexpr size_t WS_WM2 = 459 * MiB;
constexpr size_t WS_XBF = 672 * MiB;
constexpr size_t WS_WINF = 704 * MiB;
constexpr int NWIN16 = 29 * 256;
constexpr size_t WS_XB = 907 * MiB;
constexpr size_t WS_X1 = 972 * MiB;
constexpr size_t WS_PROJ = 1037 * MiB;
constexpr size_t WS_QM = 1461 * MiB;
constexpr size_t WS_KVM = 1509 * MiB;
constexpr size_t WS_HID = WS_PROJ;
constexpr size_t WS_XGFR = 1280 * MiB;
static_assert(WS_PROJ + (size_t)(136 * 256) * 7168 <= WS_XGFR && WS_XGFR + (size_t)8 * 16384 * 2048 <= 1573 * MiB, "ws map: XGFR between the MoE hidden and OATT");
constexpr size_t WS_OATT = 1573 * MiB;
constexpr size_t WS_MERGED = 1669 * MiB;
constexpr size_t WS_YMOE = WS_OATT;
constexpr size_t WS_Y = 1733 * MiB;
constexpr size_t WS_END = 1870 * MiB;
static_assert(WS_PROJ + (size_t)MTOK * NPROJ * 2 <= WS_QM && WS_HID + (size_t)(MOE_MAXT * 256) * DFFE * 2 <= WS_OATT, "ws map");
constexpr int CW_CNT = 64;
constexpr int CW_BAR = 4096;

constexpr int RING_BYTES = 131072;
constexpr int MISC_OFF = RING_BYTES + 320;
constexpr int LDS_BYTES = 147456;
constexpr int NWAVES = 8;

#define RLX_AGENT __ATOMIC_RELAXED, __HIP_MEMORY_SCOPE_AGENT
#define LDS_WAIT() asm volatile("s_waitcnt lgkmcnt(0)" ::: "memory")
#define VM_WAIT() asm volatile("s_waitcnt vmcnt(0)" ::: "memory")
#define SBAR() __builtin_amdgcn_sched_barrier(0)
__device__ __forceinline__ unsigned cvt_pk_bf16(float lo, float hi) { unsigned r; asm volatile("v_cvt_pk_bf16_f32 %0, %1, %2" : "=v"(r) : "v"(lo), "v"(hi)); return r; }
__device__ __forceinline__ u32x4 pack8(f32x4 a, f32x4 b) { u32x4 w; w.x = cvt_pk_bf16(a[0], a[1]); w.y = cvt_pk_bf16(a[2], a[3]); w.z = cvt_pk_bf16(b[0], b[1]); w.w = cvt_pk_bf16(b[2], b[3]); return w; }
__device__ __forceinline__ unsigned pk4_fp8(float a, float b, float c, float d) { int w = 0; w = __builtin_amdgcn_cvt_pk_fp8_f32(a, b, w, false); w = __builtin_amdgcn_cvt_pk_fp8_f32(c, d, w, true); return (unsigned)w; }
__device__ __forceinline__ float bf_lo(unsigned w) { return __uint_as_float(w << 16); }
__device__ __forceinline__ float bf_hi(unsigned w) { return __uint_as_float(w & 0xffff0000u); }
__device__ __forceinline__ void unpack8(u32x4 w, f32x4& a, f32x4& b) { a[0] = bf_lo(w.x); a[1] = bf_hi(w.x); a[2] = bf_lo(w.y); a[3] = bf_hi(w.y); b[0] = bf_lo(w.z); b[1] = bf_hi(w.z); b[2] = bf_lo(w.w); b[3] = bf_hi(w.w); }
__device__ __forceinline__ float fast_sigmoid(float x) { return __builtin_amdgcn_rcpf(1.0f + __builtin_amdgcn_exp2f(-x * LOG2E)); }
template <int X> __device__ __forceinline__ float swz_xor(float v) { return __int_as_float(__builtin_amdgcn_ds_swizzle(__float_as_int(v), (X << 10) | 0x1f)); }
__device__ __forceinline__ float sum_xor32(float v) { auto rr = __builtin_amdgcn_permlane32_swap(__float_as_uint(v), __float_as_uint(v), false, false); return __uint_as_float(rr[0]) + __uint_as_float(rr[1]); }
__device__ __forceinline__ float wave_sum(float v) { v += swz_xor<1>(v); v += swz_xor<2>(v); v += swz_xor<4>(v); v += swz_xor<8>(v); v += swz_xor<16>(v); return sum_xor32(v); }

__device__ __forceinline__ unsigned char* assume_global(unsigned char* p) {
#if defined(__HIP_DEVICE_COMPILE__)
    __builtin_assume(!__builtin_amdgcn_is_shared((const __attribute__((address_space(0))) void*)p) && !__builtin_amdgcn_is_private((const __attribute__((address_space(0))) void*)p));
#endif
    return p;
}
__device__ __forceinline__ int my_tid(int wave0) { int lane; asm volatile("v_mbcnt_lo_u32_b32 %0, -1, 0\n\tv_mbcnt_hi_u32_b32 %0, -1, %0" : "=v"(lane)); return wave0 * 64 + lane; }

namespace pg8 {
constexpr int BM = 256, BK = 64, HALF = 128, HTB = HALF * BK * 2, STAGE_BYTES = 8 * HTB, NXCD = 8, WGM = 8;
__host__ __device__ __forceinline__ int lds_byte(int r, int c) { const int st = (r >> 4) * 2 + (c >> 5), rr = r & 15, cc = c & 31, ob = rr * 64 + cc * 2; return st * 1024 + (ob ^ (((ob >> 9) & 1) << 5)); }
__host__ __device__ __forceinline__ void stage_rc(int b, int& R, int& C) { const int st = b / 1024, sb = b % 1024, swz = sb ^ (((sb >> 9) & 1) << 5); R = (st >> 1) * 16 + swz / 64; C = (st & 1) * 32 + (swz % 64) / 2; }
__host__ __device__ __forceinline__ int perm32(int rho) { const int n = rho >> 4, i = rho & 15; return 8 * (i >> 2) + 4 * n + (i & 3); }

struct Unit { int pm, pn, tag; unsigned A, B; };
struct Shape { int K, lda, ldb; };

__device__ __forceinline__ void tile_map(int L, int nM, int nN, int& pm, int& pn) {
    const int nwg = nM * nN; int wgid = L;
    { const int q = nwg / NXCD, r = nwg % NXCD, xcd = wgid % NXCD, off = wgid / NXCD; wgid = (xcd < r ? xcd * (q + 1) : r * (q + 1) + (xcd - r) * q) + off; }
    const int nig = WGM * nN, gid = wgid / nig, fm = gid * WGM, gsz = (nM - fm) < WGM ? (nM - fm) : WGM;
    pm = __builtin_amdgcn_readfirstlane(fm + ((wgid % nig) % gsz)); pn = __builtin_amdgcn_readfirstlane((wgid % nig) / gsz);
}

__device__ __forceinline__ const char* uni_ptr(const char* p) { const unsigned long long v = (unsigned long long)p; const unsigned lo = __builtin_amdgcn_readfirstlane((unsigned)v), hi = __builtin_amdgcn_readfirstlane((unsigned)(v >> 32)); return (const char*)(((unsigned long long)hi << 32) | lo); }
__device__ __forceinline__ void glds16_s(const char* sbase, unsigned voff, unsigned lds_dst) { unsigned keep;
    asm volatile("s_mov_b32 %0, m0\n\ts_mov_b32 m0, %3\n\ts_nop 0\n\tglobal_load_lds_dwordx4 %1, %2\n\ts_mov_b32 m0, %0" : "=&s"(keep) : "v"(voff), "s"(sbase), "s"(lds_dst) : "memory"); }
typedef int i32x8 __attribute__((ext_vector_type(8)));
typedef int i32x4 __attribute__((ext_vector_type(4)));
__device__ __forceinline__ i32x8 cat8(bf16x8 a, bf16x8 b) { return __builtin_shufflevector(__builtin_bit_cast(i32x4, a), __builtin_bit_cast(i32x4, b), 0, 1, 2, 3, 4, 5, 6, 7); }
template <class Epi, class Sched, bool FP8 = false>
__device__ __forceinline__ void gemm_phase(LAS unsigned char* lds, const char* wsb, int wave0, const Shape g, const Sched& S, const Epi& E) {
    const int tid = my_tid(wave0);
    const int wid = __builtin_amdgcn_readfirstlane(tid >> 6), lane = tid & 63, wr = wid >> 2, wc = wid & 3, fr = lane & 15, fq = lane >> 4;
    const int K = g.K, nt = K / BK;
    unsigned voffA[2], voffB[2];
#pragma unroll
    for (int i = 0; i < 2; ++i) { int R, C; stage_rc(tid * 16 + i * 8192, R, C); const int Rb = Epi::PERM ? ((R & ~31) + perm32(R & 31)) : R;
        voffA[i] = (unsigned)(R * g.lda + C) * 2u; voffB[i] = (unsigned)(Rb * g.ldb + C) * 2u; }
    const unsigned kstep = (unsigned)(BK * 2);
    const unsigned hstepA = (unsigned)HALF * g.lda * 2, hstepB = (unsigned)HALF * g.ldb * 2;
    const unsigned ldsw = (unsigned)wid * 1024u; const unsigned ldsbase = (unsigned)(size_t)lds;
    const int aoff = lds_byte(wr * 64 + fr, fq * 8), boff = lds_byte(wc * 32 + fr, fq * 8);
#define PG8_SA(b, h) (((b) * 2 + (h)) * HTB)
#define PG8_SB(b, h) ((4 + (b) * 2 + (h)) * HTB)
#define PG8_STAGE(bufoff, goff, voff) do { _Pragma("unroll") for (int _i = 0; _i < 2; ++_i) glds16_s(wsb, (voff)[_i] + (unsigned)(goff), ldsbase + (unsigned)((bufoff) + _i * 8192) + ldsw); } while (0)
#define PG8_LDA(dst, b, h) do { _Pragma("unroll") for (int m = 0; m < 4; ++m) { \
        if constexpr (FP8) { const i32x4 lo_ = *(const LAS i32x4*)(lds + PG8_SA(b, h) + aoff + m * 2048), hi_ = *(const LAS i32x4*)(lds + PG8_SA(b, h) + aoff + m * 2048 + 1024); dst##8[m] = __builtin_shufflevector(lo_, hi_, 0, 1, 2, 3, 4, 5, 6, 7); } \
        else { _Pragma("unroll") for (int k = 0; k < 2; ++k) dst[m][k] = *(const LAS bf16x8*)(lds + PG8_SA(b, h) + aoff + m * 2048 + k * 1024); } } } while (0)
#define PG8_LDB(dst, b, h) do { _Pragma("unroll") for (int n = 0; n < 2; ++n) { \
        if constexpr (FP8) { const i32x4 lo_ = *(const LAS i32x4*)(lds + PG8_SB(b, h) + boff + n * 2048), hi_ = *(const LAS i32x4*)(lds + PG8_SB(b, h) + boff + n * 2048 + 1024); dst##8[n] = __builtin_shufflevector(lo_, hi_, 0, 1, 2, 3, 4, 5, 6, 7); } \
        else { _Pragma("unroll") for (int k = 0; k < 2; ++k) dst[n][k] = *(const LAS bf16x8*)(lds + PG8_SB(b, h) + boff + n * 2048 + k * 1024); } } } while (0)
#define PG8_MMA(ai, bj, At, Bt) do { __builtin_amdgcn_s_setprio(1); \
        if constexpr (FP8) { _Pragma("unroll") for (int m = 0; m < 4; ++m) _Pragma("unroll") for (int n = 0; n < 2; ++n) \
            acc[ai][bj][m][n] = __builtin_amdgcn_mfma_scale_f32_16x16x128_f8f6f4(Bt##8[n], At##8[m], acc[ai][bj][m][n], 0, 0, 0, 0, 0, 0); } \
        else { _Pragma("unroll") for (int m = 0; m < 4; ++m) _Pragma("unroll") for (int n = 0; n < 2; ++n) _Pragma("unroll") for (int k = 0; k < 2; ++k) \
            acc[ai][bj][m][n] = __builtin_amdgcn_mfma_f32_16x16x32_bf16(Bt[n][k], At[m][k], acc[ai][bj][m][n], 0, 0, 0); } \
        __builtin_amdgcn_s_setprio(0); } while (0)
#define PG8_WAIT_V(n) asm volatile("s_waitcnt vmcnt(" #n ")" ::: "memory")
#define PG8_WAIT_L(n) asm volatile("s_waitcnt lgkmcnt(" #n ")" ::: "memory")
#define PG8_BAR __builtin_amdgcn_s_barrier()
#define PG8_SCHED __builtin_amdgcn_sched_barrier(0)
    Unit cur, nxt; int ui = 0;
    if (!S.next(0, cur)) return;
    f32x4 acc[2][2][4][2];
#define PG8_ZERO_ACC() do { _Pragma("unroll") for (int a = 0; a < 2; ++a) _Pragma("unroll") for (int b = 0; b < 2; ++b) _Pragma("unroll") for (int m = 0; m < 4; ++m) _Pragma("unroll") for (int n = 0; n < 2; ++n) \
        _Pragma("unroll") for (int j = 0; j < 4; ++j) { float z_; asm volatile("v_mov_b32 %0, 0" : "=v"(z_)); acc[a][b][m][n][j] = z_; } } while (0)
    PG8_ZERO_ACC();
    bf16x8 At[4][2], B0[2][2], B1[2][2]; i32x8 At8[4], B08[2], B18[2]; (void)At; (void)B0; (void)B1; (void)At8; (void)B08; (void)B18;
    unsigned cA = __builtin_amdgcn_readfirstlane(cur.A), cB = __builtin_amdgcn_readfirstlane(cur.B);
    PG8_STAGE(PG8_SB(0, 0), cB, voffB); PG8_STAGE(PG8_SB(0, 1), cB + hstepB, voffB); PG8_STAGE(PG8_SA(0, 0), cA, voffA); PG8_STAGE(PG8_SA(0, 1), cA + hstepA, voffA);
    if (wr == 1) PG8_BAR;
    PG8_WAIT_V(2); PG8_BAR;
    PG8_STAGE(PG8_SB(1, 0), cB + kstep, voffB); PG8_STAGE(PG8_SA(1, 0), cA + kstep, voffA); PG8_STAGE(PG8_SB(1, 1), cB + hstepB + kstep, voffB);
    PG8_WAIT_V(6); PG8_BAR;
    for (;;) {
        const bool has_next = S.next(ui + 1, nxt);
        const unsigned nA = has_next ? __builtin_amdgcn_readfirstlane(nxt.A) : cA, nB = has_next ? __builtin_amdgcn_readfirstlane(nxt.B) : cB;
        for (int t = 0; t < nt; t += 2) {
            const bool last = (t == nt - 2);
            const unsigned a1 = cA + (unsigned)(t + 1) * kstep;
            const unsigned a2 = last ? nA : cA + (unsigned)(t + 2) * kstep, b2 = last ? nB : cB + (unsigned)(t + 2) * kstep;
            const unsigned a3 = a2 + kstep, b3 = b2 + kstep;
            PG8_LDB(B0, 0, 0); PG8_LDB(B1, 0, 1); PG8_SCHED; PG8_LDA(At, 0, 0); PG8_STAGE(PG8_SA(1, 1), a1 + hstepA, voffA);
            PG8_WAIT_V(8); PG8_WAIT_L(0); PG8_BAR; PG8_MMA(0, 0, At, B0); PG8_MMA(0, 1, At, B1); PG8_BAR; PG8_SCHED;
            PG8_LDA(At, 0, 1); PG8_STAGE(PG8_SB(0, 0), b2, voffB); PG8_STAGE(PG8_SB(0, 1), b2 + hstepB, voffB); PG8_STAGE(PG8_SA(0, 0), a2, voffA);
            PG8_WAIT_V(8); PG8_WAIT_L(0); PG8_BAR; PG8_MMA(1, 0, At, B0); PG8_MMA(1, 1, At, B1); PG8_BAR; PG8_SCHED;
            PG8_LDB(B0, 1, 0); PG8_LDB(B1, 1, 1); PG8_SCHED; PG8_LDA(At, 1, 0); PG8_STAGE(PG8_SA(0, 1), a2 + hstepA, voffA);
            PG8_WAIT_V(8); PG8_WAIT_L(0); PG8_BAR; PG8_MMA(0, 0, At, B0); PG8_MMA(0, 1, At, B1); PG8_BAR; PG8_SCHED;
            PG8_LDA(At, 1, 1); PG8_STAGE(PG8_SB(1, 0), b3, voffB); PG8_STAGE(PG8_SB(1, 1), b3 + hstepB, voffB); PG8_STAGE(PG8_SA(1, 0), a3, voffA);
            PG8_WAIT_V(8); PG8_WAIT_L(0); PG8_BAR; PG8_MMA(1, 0, At, B0); PG8_MMA(1, 1, At, B1); PG8_BAR; PG8_SCHED;
        }
        if (wr == 0) PG8_BAR;
        { const int l2 = my_tid(wave0) & 63;
          E(acc, cur, wr, wc, l2 & 15, l2 >> 4); }
        if (!has_next) break;
        PG8_ZERO_ACC();
        cur = nxt; cA = nA; cB = nB; ++ui;
        if (wr == 1) PG8_BAR;
    }
    PG8_WAIT_V(0);
    PG8_BAR;
#undef PG8_ZERO_ACC
#undef PG8_SA
#undef PG8_SB
#undef PG8_STAGE
#undef PG8_LDA
#undef PG8_LDB
#undef PG8_MMA
#undef PG8_WAIT_V
#undef PG8_WAIT_L
#undef PG8_BAR
#undef PG8_SCHED
}
}

struct SchedPlain {
    int nM, nN, G, c; unsigned A, B, tA, tB;
    __device__ __forceinline__ bool next(int i, pg8::Unit& u) const {
        const long L = (long)i * G + c; if (L >= (long)nM * nN) return false;
        pg8::tile_map((int)L, nM, nN, u.pm, u.pn); u.tag = 0; u.A = A + (unsigned)u.pm * tA; u.B = B + (unsigned)u.pn * tB; return true;
    }
};
struct SchedGates {
    int G, c; unsigned A, B;
    __device__ __forceinline__ bool next(int i, pg8::Unit& u) const {
        long L;
        if (G == 256) { if (i < 5) L = (long)i * 256 + c; else if (i == 5) { if (c < 64) return false; L = 1280 + (c - 64); } else if (i == 6) { if (c < 64 || c >= 128) return false; L = 1472 + (c - 64); } else return false; }
        else { L = (long)i * G + c; if (L >= 64 * 24) return false; }
        pg8::tile_map((int)L, 64, 24, u.pm, u.pn); u.tag = 0; u.A = A + (unsigned)u.pm * (256u * DM); u.B = B + (unsigned)u.pn * (256u * DM); return true;
    }
};
struct SchedMlaUp {
    int G, c; unsigned Aq, Akv, Bq, Bkv;
    __device__ __forceinline__ bool next(int i, pg8::Unit& u) const {
        const long L = (long)i * G + c; if (L >= 64 * 14) return false;
        int pm, pv; pg8::tile_map((int)L, 64, 14, pm, pv); u.pm = pm;
        const unsigned tA = 256u * NPROJ * 2, tB = 256u * QLORA * 2;
        if (pv < 6) { u.pn = pv; u.tag = 0; u.A = Aq + (unsigned)pm * tA; u.B = Bq + (unsigned)pv * tB; }
        else { u.pn = pv - 6; u.tag = 1; u.A = Akv + (unsigned)pm * tA; u.B = Bkv + (unsigned)(pv - 6) * tB; }
        return true;
    }
};
struct SchedMerge {
    int G, c; unsigned A, B;
    __device__ __forceinline__ bool next(int i, pg8::Unit& u) const {
        const int r = i / 3, br = i - 3 * r; const long L = (long)r * G + c; if (L >= 512) return false;
        pg8::tile_map((int)L, 64, 8, u.pm, u.pn); u.tag = br;
        u.A = A + (unsigned)u.pm * (256u * NOATT * 2) + (unsigned)br * 2048u; u.B = B + (unsigned)br * ((unsigned)DM * 1024 * 2) + (unsigned)u.pn * (256u * 1024 * 2); return true;
    }
};
struct SchedMoe {
    int nM, nN, G, c; unsigned A, B, tA, tB, eB; unsigned long long tbp; int regA;
    __device__ __forceinline__ bool next(int i, pg8::Unit& u) const {
        const long L = (long)i * G + c; if (L >= (long)nM * nN) return false;
        pg8::tile_map((int)L, nM, nN, u.pm, u.pn); int e = 0;
#pragma unroll
        for (int j = 0; j < 7; ++j) e += (u.pm >= (int)((tbp >> (8 * j)) & 255ull)) ? 1 : 0;
        e = __builtin_amdgcn_readfirstlane(e);
        const int tbe = (e == 0) ? 0 : (int)((tbp >> (8 * (e - 1))) & 255ull);
        u.tag = e; u.A = regA ? A + ((unsigned)e * (unsigned)(MTOK / 256) + (unsigned)(u.pm - tbe)) * tA : A + (unsigned)u.pm * tA; u.B = B + (unsigned)e * eB + (unsigned)u.pn * tB; return true;
    }
};

struct EpiInProj {
    static constexpr bool PERM = true;
    bf16_t* proj; float* ssq; const float* cosT; const float* sinT; bf16_t* kpe; float* lf; const float* bforget;
    __device__ __forceinline__ void operator()(const f32x4 (&acc)[2][2][4][2], const pg8::Unit& u, int wr, int wc, int fr, int fq) const {
        const int row0 = u.pm * 256 + wr * 64 + fr, col0 = wc * 32 + 8 * fq;
        if (u.pn < 28) {
            const float sc = __int_as_float(__builtin_amdgcn_readfirstlane((u.pn < 4 || (u.pn >= 12 && u.pn < 16)) ? __float_as_int(C2_128) : __float_as_int(1.0f)));
            const bool dossq = (u.pn >= 24 && u.pn < 28);
#pragma unroll
            for (int ai = 0; ai < 2; ++ai)
#pragma unroll
                for (int m = 0; m < 4; ++m) { const int row = row0 + ai * 128 + m * 16; bf16_t* rowp = proj + (size_t)row * NPROJ + u.pn * 256 + col0; float s = 0.f;
#pragma unroll
                    for (int bj = 0; bj < 2; ++bj) { const f32x4 v0 = acc[ai][bj][m][0] * sc, v1 = acc[ai][bj][m][1] * sc;
                        s += (v0[0] * v0[0] + v0[1] * v0[1]) + (v0[2] * v0[2] + v0[3] * v0[3]) + (v1[0] * v1[0] + v1[1] * v1[1]) + (v1[2] * v1[2] + v1[3] * v1[3]);
                        *(u32x4*)(rowp + bj * 128) = pack8(v0, v1); }
                    if (dossq) { s += swz_xor<16>(s); s = sum_xor32(s); if (fq == 0) ssq[(size_t)row * 16 + (u.pn - 24) * 4 + wc] = s; } }
        } else {
            if (wc < 2) {
#pragma unroll
                for (int ai = 0; ai < 2; ++ai)
#pragma unroll
                    for (int m = 0; m < 4; ++m) { const int row = row0 + ai * 128 + m * 16; const int i0 = 16 * wc + 4 * fq;
                        const f32x4 cs = *(const f32x4*)(cosT + (size_t)row * 32 + i0), sn = *(const f32x4*)(sinT + (size_t)row * 32 + i0);
                        const f32x4 v0 = acc[ai][0][m][0], v1 = acc[ai][0][m][1]; f32x4 o0, o1;
                        o0[0] = v0[0] * cs[0] - v0[1] * sn[0]; o0[1] = v0[1] * cs[0] + v0[0] * sn[0]; o0[2] = v0[2] * cs[1] - v0[3] * sn[1]; o0[3] = v0[3] * cs[1] + v0[2] * sn[1];
                        o1[0] = v1[0] * cs[2] - v1[1] * sn[2]; o1[1] = v1[1] * cs[2] + v1[0] * sn[2]; o1[2] = v1[2] * cs[3] - v1[3] * sn[3]; o1[3] = v1[3] * cs[3] + v1[2] * sn[3];
                        *(u32x4*)(kpe + (size_t)row * 64 + col0) = pack8(o0, o1); }
            } else if (wc == 2 && fq == 0) {
                const f32x4 b0 = *(const f32x4*)(bforget), b1 = *(const f32x4*)(bforget + 4);
#pragma unroll
                for (int ai = 0; ai < 2; ++ai)
#pragma unroll
                    for (int m = 0; m < 4; ++m) { const int row = row0 + ai * 128 + m * 16; f32x4 z0 = acc[ai][0][m][0] + b0, z1 = acc[ai][0][m][1] + b1;
#pragma unroll
                        for (int j = 0; j < 4; ++j) { z0[j] = fminf(z0[j], 0.f) - log1pf(expf(-fabsf(z0[j]))); z1[j] = fminf(z1[j], 0.f) - log1pf(expf(-fabsf(z1[j]))); }
                        *(f32x4*)(lf + (size_t)row * 8) = z0; *(f32x4*)(lf + (size_t)row * 8 + 4) = z1; }
            }
        }
    }
};
struct EpiGates8 {
    static constexpr bool PERM = true;
    bf16_t* proj;
    __device__ __forceinline__ void operator()(const f32x4 (&acc)[2][2][4][2], const pg8::Unit& u, int wr, int wc, int fr, int fq) const {
        const int row0 = u.pm * 256 + wr * 64 + fr, col0 = C_GATE + u.pn * 256 + wc * 32 + 8 * fq; const float ds = 1.0f / (X_SCALE * W13_SCALE);
#pragma unroll
        for (int ai = 0; ai < 2; ++ai)
#pragma unroll
            for (int m = 0; m < 4; ++m) { bf16_t* rowp = proj + (size_t)(row0 + ai * 128 + m * 16) * NPROJ + col0;
#pragma unroll
                for (int bj = 0; bj < 2; ++bj) *(u32x4*)(rowp + bj * 128) = pack8(acc[ai][bj][m][0] * ds, acc[ai][bj][m][1] * ds); }
    }
};
struct EpiMlaUp {
    static constexpr bool PERM = true;
    bf16_t* qm; bf16_t* kvm; const float* ssq; const float* cosT; const float* sinT;
    __device__ __forceinline__ void operator()(const f32x4 (&acc)[2][2][4][2], const pg8::Unit& u, int wr, int wc, int fr, int fq) const {
        const int row0 = u.pm * 256 + wr * 64 + fr, col0 = wc * 32 + 8 * fq;
#pragma unroll
        for (int ai = 0; ai < 2; ++ai)
#pragma unroll
            for (int m = 0; m < 4; ++m) { const int row = row0 + ai * 128 + m * 16;
                const f32x4 s0 = *(const f32x4*)(ssq + (size_t)row * 16 + u.tag * 8), s1 = *(const f32x4*)(ssq + (size_t)row * 16 + u.tag * 8 + 4);
                const float ss = ((s0[0] + s0[1]) + (s0[2] + s0[3])) + ((s1[0] + s1[1]) + (s1[2] + s1[3]));
                float rs = 1.0f / sqrtf(ss * (1.0f / 512.0f) + RMS_EPS);
                if (u.tag == 0) {
                    rs *= C2_192; bf16_t* rowp = qm + (size_t)row * NQM + u.pn * 256 + col0;
                    if (u.pn < 4) {
#pragma unroll
                        for (int bj = 0; bj < 2; ++bj) *(u32x4*)(rowp + bj * 128) = pack8(acc[ai][bj][m][0] * rs, acc[ai][bj][m][1] * rs);
                    } else {
#pragma unroll
                        for (int bj = 0; bj < 2; ++bj) { const int jj = (bj * 128 + col0) & 63, i0 = jj >> 1;
                            const f32x4 cs = *(const f32x4*)(cosT + (size_t)row * 32 + i0), sn = *(const f32x4*)(sinT + (size_t)row * 32 + i0);
                            const f32x4 v0 = acc[ai][bj][m][0] * rs, v1 = acc[ai][bj][m][1] * rs; f32x4 o0, o1;
                            o0[0] = v0[0] * cs[0] - v0[1] * sn[0]; o0[1] = v0[1] * cs[0] + v0[0] * sn[0]; o0[2] = v0[2] * cs[1] - v0[3] * sn[1]; o0[3] = v0[3] * cs[1] + v0[2] * sn[1];
                            o1[0] = v1[0] * cs[2] - v1[1] * sn[2]; o1[1] = v1[1] * cs[2] + v1[0] * sn[2]; o1[2] = v1[2] * cs[3] - v1[3] * sn[3]; o1[3] = v1[3] * cs[3] + v1[2] * sn[3];
                            *(u32x4*)(rowp + bj * 128) = pack8(o0, o1); }
                    }
                } else {
                    bf16_t* rowp = kvm + (size_t)row * NKVM + u.pn * 256 + col0;
#pragma unroll
                    for (int bj = 0; bj < 2; ++bj) *(u32x4*)(rowp + bj * 128) = pack8(acc[ai][bj][m][0] * rs, acc[ai][bj][m][1] * rs);
                }
            }
    }
};
struct EpiGateMerge {
    static constexpr bool PERM = true;
    const bf16_t* proj; bf16_t* merged;
    __device__ __forceinline__ void operator()(const f32x4 (&acc)[2][2][4][2], const pg8::Unit& u, int wr, int wc, int fr, int fq) const {
        const int row0 = u.pm * 256 + wr * 64 + fr, col0 = u.pn * 256 + wc * 32 + 8 * fq;
#pragma unroll
        for (int ai = 0; ai < 2; ++ai)
#pragma unroll
            for (int m = 0; m < 4; ++m) { const int row = row0 + ai * 128 + m * 16;
#pragma unroll
                for (int bj = 0; bj < 2; ++bj) { const int col = col0 + bj * 128;
                    const u32x4 gw = *(const u32x4*)(proj + (size_t)row * NPROJ + C_GATE + u.tag * 2048 + col); f32x4 g0, g1; unpack8(gw, g0, g1);
                    f32x4 v0 = acc[ai][bj][m][0], v1 = acc[ai][bj][m][1];
#pragma unroll
                    for (int j = 0; j < 4; ++j) { v0[j] *= fast_sigmoid(g0[j]); v1[j] *= fast_sigmoid(g1[j]); }
                    bf16_t* op = merged + (size_t)row * DM + col;
                    if (u.tag > 0) { const u32x4 pw = *(const u32x4*)op; f32x4 p0, p1; unpack8(pw, p0, p1); v0 += p0; v1 += p1; }
                    *(u32x4*)op = pack8(v0, v1); } }
    }
};
struct EpiResidual {
    static constexpr bool PERM = true;
    const bf16_t* res; bf16_t* y;
    __device__ __forceinline__ void operator()(const f32x4 (&acc)[2][2][4][2], const pg8::Unit& u, int wr, int wc, int fr, int fq) const {
        const int row0 = u.pm * 256 + wr * 64 + fr, col0 = u.pn * 256 + wc * 32 + 8 * fq;
#pragma unroll
        for (int ai = 0; ai < 2; ++ai)
#pragma unroll
            for (int m = 0; m < 4; ++m) { const size_t off = (size_t)(row0 + ai * 128 + m * 16) * DM + col0;
#pragma unroll
                for (int bj = 0; bj < 2; ++bj) { const u32x4 rw = *(const u32x4*)(res + off + bj * 128); f32x4 r0, r1; unpack8(rw, r0, r1);
                    *(u32x4*)(y + off + bj * 128) = pack8(r0 * ALPHA + acc[ai][bj][m][0], r1 * ALPHA + acc[ai][bj][m][1]); } }
    }
};
struct EpiSwiGLU {
    static constexpr bool PERM = true;
    bf16_t* hid; int ldh;
    __device__ __forceinline__ void operator()(const f32x4 (&acc)[2][2][4][2], const pg8::Unit& u, int wr, int wc, int fr, int fq) const {
        const int row0 = u.pm * 256 + wr * 64 + fr, col0 = u.pn * 128 + wc * 32 + 8 * fq;
#pragma unroll
        for (int ai = 0; ai < 2; ++ai)
#pragma unroll
            for (int m = 0; m < 4; ++m) { f32x4 h0, h1;
#pragma unroll
                for (int j = 0; j < 4; ++j) { const float a0 = acc[ai][0][m][0][j], a1 = acc[ai][0][m][1][j];
                    h0[j] = a0 * fast_sigmoid(a0) * acc[ai][1][m][0][j]; h1[j] = a1 * fast_sigmoid(a1) * acc[ai][1][m][1][j]; }
                *(u32x4*)(hid + (size_t)(row0 + ai * 128 + m * 16) * ldh + col0) = pack8(h0, h1); }
    }
};
struct EpiSwiGLU8 {
    static constexpr bool PERM = true;
    unsigned char* hid; int ldh;
    __device__ __forceinline__ void operator()(const f32x4 (&acc)[2][2][4][2], const pg8::Unit& u, int wr, int wc, int fr, int fq) const {
        const int row0 = u.pm * 256 + wr * 64 + fr, col0 = u.pn * 128 + wc * 32 + 8 * fq; const float ds = 1.0f / (X_SCALE * W13_SCALE);
#pragma unroll
        for (int ai = 0; ai < 2; ++ai)
#pragma unroll
            for (int m = 0; m < 4; ++m) { f32x4 h0, h1;
#pragma unroll
                for (int j = 0; j < 4; ++j) { const float a0 = acc[ai][0][m][0][j] * ds, a1 = acc[ai][0][m][1][j] * ds;
                    h0[j] = a0 * fast_sigmoid(a0) * (acc[ai][1][m][0][j] * (ds * H_SCALE)); h1[j] = a1 * fast_sigmoid(a1) * (acc[ai][1][m][1][j] * (ds * H_SCALE)); }
                u32x2 w; w.x = pk4_fp8(h0[0], h0[1], h0[2], h0[3]); w.y = pk4_fp8(h1[0], h1[1], h1[2], h1[3]);
                *(u32x2*)(hid + (size_t)(row0 + ai * 128 + m * 16) * ldh + col0) = w; }
    }
};
struct EpiMoeDown {
    static constexpr bool PERM = true;
    bf16_t* ymoe; const int* ldst; const float* lgate; unsigned long long tbp; const unsigned* cntp;
    __device__ __forceinline__ void operator()(const f32x4 (&acc)[2][2][4][2], const pg8::Unit& u, int wr, int wc, int fr, int fq) const {
        const int e = u.tag; const int tbe = (int)((tbp >> (8 * e)) & 255ull);
        int ce = (int)__hip_atomic_load(cntp + e, RLX_AGENT); if (ce > MTOK) ce = MTOK;
        const int pos0 = (u.pm - tbe) * 256 + wr * 64 + fr, col0 = u.pn * 256 + wc * 32 + 8 * fq;
#pragma unroll
        for (int ai = 0; ai < 2; ++ai)
#pragma unroll
            for (int m = 0; m < 4; ++m) { const int pos = pos0 + ai * 128 + m * 16;
                if (pos < ce) { const int dst = ldst[e * MTOK + pos]; const float gt = lgate[e * MTOK + pos] * (1.0f / (H_SCALE * W2_SCALE)); bf16_t* rowp = ymoe + (size_t)dst * DM + col0;
#pragma unroll
                    for (int bj = 0; bj < 2; ++bj) *(u32x4*)(rowp + bj * 128) = pack8(acc[ai][bj][m][0] * gt, acc[ai][bj][m][1] * gt); } }
    }
};

namespace att {
constexpr int KVBLK = 64, QBLK = 32, QB = 256;
constexpr int SHM_V = 16384, SHM_K = 16384, SHM_KPE = 8192;
constexpr int L_V = 0, L_K = 2 * SHM_V, L_KPE = L_K + 2 * SHM_K, L_BIAS = L_KPE + 2 * SHM_KPE, L_TAB = L_BIAS + 512, L_WS = L_TAB + 256, L_NEED = L_WS + 8 * 256, L_END = L_NEED + 256, L_OST = 0;
static_assert(L_END <= RING_BYTES, "attention LDS");
constexpr float THRL = 8.0f;
#define KSWZ(row, colB) ((row) * 256 + ((colB) ^ (((row) & 7) << 4)))
__device__ __forceinline__ int v_st(int k, int c) { const int kk = (k & ~0xC) | ((k & 4) << 1) | ((k & 8) >> 1); return ((kk >> 3) * 4 + (c >> 5)) * 512 + ((kk & 7) * 32 + (c & 31)) * 2; }
__device__ __forceinline__ int v_rd_base(int lane) { return ((lane & 3) << 3) | (((lane >> 2) & 3) << 6) | (((lane >> 4) & 1) << 5) | (((lane >> 5) & 1) << 8); }
__device__ __forceinline__ int crow(int r, int hi) { return (r & 3) + 8 * (r >> 2) + 4 * hi; }
enum { MOBA = 0, FOX = 1, MLA = 2 };
struct Args { const bf16_t* q; int ldq; const bf16_t* qr; const bf16_t* k; int ldk; const bf16_t* kr; const bf16_t* v; int ldv; bf16_t* o; const float* cb; const bf16_t* kmh; const bf16_t* kml; };

template <int MODE>
__device__ __forceinline__ void attn_unit(const Args& a, int b, int h, int qb, LAS unsigned char* lds, int wave0) {
    const int tid = my_tid(wave0);
    const int wid = __builtin_amdgcn_readfirstlane(tid >> 6), lane = tid & 63, r32 = lane & 31, hi = lane >> 5;
    const size_t rowbase = (size_t)b * SEQ; const int q0 = qb * QB;
    LAS unsigned char* V_lds = lds + L_V; LAS unsigned char* K_lds = lds + L_K; LAS unsigned char* P_lds = lds + L_KPE;
    LAS float* bias_l = (LAS float*)(lds + L_BIAS); LAS float* tab_l = (LAS float*)(lds + L_TAB);
    LAS float* wsf = (LAS float*)(lds + L_WS) + wid * 64; LAS float* li_l = wsf; LAS float* al_l = wsf + 32;
    LAS unsigned* need_l = (LAS unsigned*)(lds + L_NEED);
    const bf16_t* Qg = a.q + (rowbase + q0 + wid * QBLK + r32) * (size_t)a.ldq + h * HD;
    const bf16_t* Kg = a.k + rowbase * (size_t)a.ldk + h * HD;
    const bf16_t* Vg = a.v + rowbase * (size_t)a.ldv + h * HD;
    bf16x8 qr[MODE == MLA ? 12 : 8];
#pragma unroll
    for (int d0 = 0; d0 < 8; ++d0) qr[d0] = *(const bf16x8*)(Qg + d0 * 16 + hi * 8);
    if constexpr (MODE == MLA) { const bf16_t* Qr = a.qr + (rowbase + q0 + wid * QBLK + r32) * (size_t)a.ldq + h * 64;
#pragma unroll
        for (int d0 = 0; d0 < 4; ++d0) qr[8 + d0] = *(const bf16x8*)(Qr + d0 * 16 + hi * 8); }
    int koff[2], voff[2], poff = 0;
#pragma unroll
    for (int j = 0; j < 2; ++j) { const int pc = wid * 2 + j;
        { const int row = pc * 4 + (lane >> 4), ch = (lane & 15) ^ (row & 7); koff[j] = row * a.ldk + ch * 8; }
        { const int st = pc * 2 + (lane >> 5), kk = (st >> 2) * 8 + ((lane & 31) >> 2), c = (st & 3) * 32 + (lane & 3) * 8; const int k = (kk & ~0xC) | ((kk & 4) << 1) | ((kk & 8) >> 1); voff[j] = k * a.ldv + c; } }
    if constexpr (MODE == MLA) { const int row = wid * 8 + (lane >> 3), ch = (lane & 7) ^ (row & 7); poff = row * 64 + ch * 8; }
    const int vb0 = (int)(uintptr_t)V_lds + v_rd_base(lane);
    const LAS unsigned char* kb4[4];
#pragma unroll
    for (int dd = 0; dd < 4; ++dd) kb4[dd] = K_lds + KSWZ(r32, (dd * 16 + hi * 8) * 2);
    const LAS unsigned char* pb4[4];
#pragma unroll
    for (int dd = 0; dd < 4; ++dd) pb4[dd] = P_lds + r32 * 128 + (((dd * 2 + hi) * 16) ^ ((r32 & 7) << 4));
    const int NBLK = qb + 1;
    unsigned need = (1u << NBLK) - 1u; unsigned selmask = need;
    float sl2 = 0.f;
    if constexpr (MODE == MOBA) {
        sl2 = __builtin_amdgcn_exp2f(-(float)(h + 1)) * LOG2E;
        if (tid < 64) tab_l[tid] = sl2 * (float)tid;
        if (tid == 0) need_l[0] = 0u;
        { const int sr = tid >> 4, sc = (tid & 15) * 8, kws = KSWZ(sr, sc * 2);
          const size_t kmoff = ((size_t)(b * NHEAD + h) * 16) * HD; u32x4 z;
#pragma unroll
          for (int j = 0; j < 4; ++j) { unsigned z_; asm volatile("v_mov_b32 %0, 0" : "=v"(z_)); z[j] = z_; }
          if (tid < 256) { *(LAS u32x4*)(K_lds + kws) = *(const u32x4*)(a.kmh + kmoff + (size_t)sr * HD + sc); *(LAS u32x4*)(K_lds + SHM_K + kws) = *(const u32x4*)(a.kml + kmoff + (size_t)sr * HD + sc); }
          else { *(LAS u32x4*)(K_lds + kws) = z; *(LAS u32x4*)(K_lds + SHM_K + kws) = z; } }
        __syncthreads();
        f32x16 g = {};
#pragma unroll
        for (int d0 = 0; d0 < 8; ++d0) { const LAS unsigned char* ap = kb4[d0 & 3] + (d0 >> 2) * 128;
            const bf16x8 kh = *(const LAS bf16x8*)ap, kl = *(const LAS bf16x8*)(ap + SHM_K);
            g = __builtin_amdgcn_mfma_f32_32x32x16_bf16(kh, qr[d0], g, 0, 0, 0); g = __builtin_amdgcn_mfma_f32_32x32x16_bf16(kl, qr[d0], g, 0, 0, 0); }
        float val[16];
#pragma unroll
        for (int i = 0; i < 8; ++i) { auto rr = __builtin_amdgcn_permlane32_swap(__float_as_uint(g[i]), __float_as_uint(g[i]), false, false);
            const int nlo = (i & 3) + 8 * (i >> 2); val[nlo] = __uint_as_float(rr[0]); val[nlo + 4] = __uint_as_float(rr[1]); }
        const float NEGI = -__builtin_inff();
#pragma unroll
        for (int n = 0; n < 16; ++n) if (n >= qb) val[n] = NEGI;
        unsigned sel = 0u;
#pragma unroll
        for (int pass = 0; pass < 3; ++pass) { float best = NEGI; int bi = -1;
#pragma unroll
            for (int n = 0; n < 16; ++n) if (val[n] > best) { best = val[n]; bi = n; }
#pragma unroll
            for (int n = 0; n < 16; ++n) if (n == bi) { val[n] = NEGI; sel |= (1u << n); } }
        selmask = sel | (1u << qb);
        unsigned wneed = 0u;
#pragma unroll
        for (int n = 0; n < 16; ++n) if (__ballot((selmask >> n) & 1u) != 0ull) wneed |= (1u << n);
        if (lane == 0) atomicOr((unsigned*)need_l, wneed);
        __syncthreads();
        need = (unsigned)__builtin_amdgcn_readfirstlane((int)need_l[0]);
    }
    float m_reg = -1e30f, l_reg = 0.f; f32x16 o[4] = {};
    const int qpos = q0 + wid * QBLK + r32;
    const int qlo = q0 + wid * QBLK;
    const LAS float* bt = (MODE == FOX) ? (const LAS float*)(bias_l + 4 * hi) : (const LAS float*)(tab_l + 4 * hi);
#define T_DMA(kb, BUFN) do { \
        _Pragma("unroll") for (int j_ = 0; j_ < 2; ++j_) { \
            __builtin_amdgcn_global_load_lds((const unsigned*)(Kg + (size_t)(kb) * a.ldk + koff[j_]), (LAS unsigned*)(K_lds + (BUFN) * SHM_K + (wid * 2 + j_) * 1024), 16, 0, 0); \
            __builtin_amdgcn_global_load_lds((const unsigned*)(Vg + (size_t)(kb) * a.ldv + voff[j_]), (LAS unsigned*)(V_lds + (BUFN) * SHM_V + (wid * 2 + j_) * 1024), 16, 0, 0); } \
        if constexpr (MODE == MLA) __builtin_amdgcn_global_load_lds((const unsigned*)(a.kr + (rowbase + (kb)) * 64 + poff), (LAS unsigned*)(P_lds + (BUFN) * SHM_KPE + wid * 1024), 16, 0, 0); \
        if constexpr (MODE == FOX) { if (wid == 0) __builtin_amdgcn_global_load_lds((const unsigned*)(a.cb + (size_t)(b * NHEAD + h) * SEQ + (kb) + lane), (LAS unsigned*)(bias_l + (BUFN) * 64), 4, 0, 0); } } while (0)
#define PK4(P, B_, OUT) do { unsigned a0_ = cvt_pk_bf16(P[B_ + 0], P[B_ + 1]), a1_ = cvt_pk_bf16(P[B_ + 2], P[B_ + 3]), b0_ = cvt_pk_bf16(P[B_ + 4], P[B_ + 5]), b1_ = cvt_pk_bf16(P[B_ + 6], P[B_ + 7]); \
        auto r0_ = __builtin_amdgcn_permlane32_swap(a0_, b0_, false, false); auto r1_ = __builtin_amdgcn_permlane32_swap(a1_, b1_, false, false); \
        u32x4 w_ = {r0_[0], r1_[0], r0_[1], r1_[1]}; OUT = __builtin_bit_cast(bf16x8, w_); } while (0)
#define TRRD(dst, off_) asm volatile("ds_read_b64_tr_b16 %0, %1 offset:%2" : "=&v"(dst) : "v"(vb0), "i"(off_) : "memory")
#define PV_D0(BUF, d0) do { s16x4 l0, l1, l2, l3, h0, h1, h2, h3; constexpr int b_ = (BUF) * SHM_V + (d0) * 512; \
        TRRD(l0, b_); TRRD(h0, b_ + 2048); TRRD(l1, b_ + 4096); TRRD(h1, b_ + 6144); TRRD(l2, b_ + 8192); TRRD(h2, b_ + 10240); TRRD(l3, b_ + 12288); TRRD(h3, b_ + 14336); \
        asm volatile("s_waitcnt lgkmcnt(0)" ::: "memory"); SBAR(); \
        o[d0] = __builtin_amdgcn_mfma_f32_32x32x16_bf16(pa0, (bf16x8){l0[0], l0[1], l0[2], l0[3], h0[0], h0[1], h0[2], h0[3]}, o[d0], 0, 0, 0); \
        o[d0] = __builtin_amdgcn_mfma_f32_32x32x16_bf16(pa1, (bf16x8){l1[0], l1[1], l1[2], l1[3], h1[0], h1[1], h1[2], h1[3]}, o[d0], 0, 0, 0); \
        o[d0] = __builtin_amdgcn_mfma_f32_32x32x16_bf16(pa2, (bf16x8){l2[0], l2[1], l2[2], l2[3], h2[0], h2[1], h2[2], h2[3]}, o[d0], 0, 0, 0); \
        o[d0] = __builtin_amdgcn_mfma_f32_32x32x16_bf16(pa3, (bf16x8){l3[0], l3[1], l3[2], l3[3], h3[0], h3[1], h3[2], h3[3]}, o[d0], 0, 0, 0); } while (0)
#define TILE(BUF, kb_, HASN, nkb_) do { const int kb = (kb_); \
        if (HASN) T_DMA((nkb_), (BUF) ^ 1); \
        SBAR(); \
        f32x16 p0, p1; \
        if constexpr (MODE == MLA) { p0 = f32x16{}; p1 = f32x16{}; } \
        else { const LAS float* btb = bt + (MODE == FOX ? (BUF) * 64 : 0); \
            _Pragma("unroll") for (int gq = 0; gq < 4; ++gq) { const f32x4 b0 = *(const LAS f32x4*)(btb + 8 * gq), b1 = *(const LAS f32x4*)(btb + 32 + 8 * gq); \
                _Pragma("unroll") for (int j = 0; j < 4; ++j) { p0[4 * gq + j] = b0[j]; p1[4 * gq + j] = b1[j]; } } } \
        _Pragma("unroll") for (int d0 = 0; d0 < 8; ++d0) { const LAS unsigned char* ap = kb4[d0 & 3] + (d0 >> 2) * 128 + (BUF) * SHM_K; \
            const bf16x8 k0 = *(const LAS bf16x8*)ap, k1 = *(const LAS bf16x8*)(ap + 32 * 256); \
            p0 = __builtin_amdgcn_mfma_f32_32x32x16_bf16(k0, qr[d0], p0, 0, 0, 0); p1 = __builtin_amdgcn_mfma_f32_32x32x16_bf16(k1, qr[d0], p1, 0, 0, 0); } \
        if constexpr (MODE == MLA) { \
            _Pragma("unroll") for (int d0 = 0; d0 < 4; ++d0) { const LAS unsigned char* ap = pb4[d0] + (BUF) * SHM_KPE; \
                const bf16x8 k0 = *(const LAS bf16x8*)ap, k1 = *(const LAS bf16x8*)(ap + 32 * 128); \
                p0 = __builtin_amdgcn_mfma_f32_32x32x16_bf16(k0, qr[8 + d0], p0, 0, 0, 0); p1 = __builtin_amdgcn_mfma_f32_32x32x16_bf16(k1, qr[8 + d0], p1, 0, 0, 0); } } \
        const float NEG = -__builtin_inff(); \
        if (blk == qb && kb + KVBLK - 1 > qlo) { const int dq = qpos - kb - 4 * hi; \
            _Pragma("unroll") for (int r = 0; r < 16; ++r) { const int c = (r & 3) + 8 * (r >> 2); if (dq - c < 0) p0[r] = NEG; if (dq - c - 32 < 0) p1[r] = NEG; } } \
        if constexpr (MODE == MOBA) { if (((selmask >> blk) & 1u) == 0u) { \
            _Pragma("unroll") for (int r = 0; r < 16; ++r) { p0[r] = NEG; p1[r] = NEG; } } } \
        float aoff = 0.f; if constexpr (MODE == MOBA) aoff = sl2 * (float)(kb - qpos); \
        float pmax = p0[0]; \
        _Pragma("unroll") for (int r = 1; r < 16; ++r) pmax = fmaxf(pmax, p0[r]); \
        _Pragma("unroll") for (int r = 0; r < 16; ++r) pmax = fmaxf(pmax, p1[r]); \
        { auto rr = __builtin_amdgcn_permlane32_swap(__float_as_uint(pmax), __float_as_uint(pmax), false, false); pmax = fmaxf(__uint_as_float(rr[0]), __uint_as_float(rr[1])); } \
        pmax += aoff; \
          \
        const bool dead_ = (MODE != MLA) && __all(pmax - m_reg < -150.f); \
        if (!dead_) { \
        float alpha = 1.f; \
        if (!__all(pmax - m_reg <= THRL)) { const float mn = fmaxf(m_reg, pmax); alpha = __builtin_amdgcn_exp2f(m_reg - mn); m_reg = mn; } \
        const float off = aoff - m_reg; \
        _Pragma("unroll") for (int r = 0; r < 16; ++r) { p0[r] = __builtin_amdgcn_exp2f(p0[r] + off); p1[r] = __builtin_amdgcn_exp2f(p1[r] + off); } \
        float ps = 0.f; \
        _Pragma("unroll") for (int r = 0; r < 16; ++r) ps += p0[r]; \
        _Pragma("unroll") for (int r = 0; r < 16; ++r) ps += p1[r]; \
        { auto rr = __builtin_amdgcn_permlane32_swap(__float_as_uint(ps), __float_as_uint(ps), false, false); ps = __uint_as_float(rr[0]) + __uint_as_float(rr[1]); } \
        l_reg = l_reg * alpha + ps; \
        bf16x8 pa0, pa1, pa2, pa3; \
        PK4(p0, 0, pa0); PK4(p0, 8, pa1); PK4(p1, 0, pa2); PK4(p1, 8, pa3); \
        if (__any(alpha < 1.f)) { if (hi == 0) al_l[r32] = alpha; LDS_WAIT(); \
            _Pragma("unroll") for (int d_ = 0; d_ < 4; ++d_) _Pragma("unroll") for (int r = 0; r < 16; ++r) o[d_][r] *= al_l[crow(r, hi)]; } \
        PV_D0(BUF, 0); PV_D0(BUF, 1); PV_D0(BUF, 2); PV_D0(BUF, 3); } \
        if (HASN) { VM_WAIT(); __syncthreads(); } } while (0)
    int blk = 31 - __builtin_clz(need);
    T_DMA(blk * 256 + 192, 0); VM_WAIT(); __syncthreads();
    for (;;) {
        const unsigned rest = need & ((1u << blk) - 1u); const bool more = rest != 0u; const int nblk = more ? 31 - __builtin_clz(rest) : blk;
        TILE(0, blk * 256 + 192, true, blk * 256 + 128);
        TILE(1, blk * 256 + 128, true, blk * 256 + 64);
        TILE(0, blk * 256 + 64, true, blk * 256);
        TILE(1, blk * 256, more, nblk * 256 + 192);
        if (!more) break;
        blk = nblk;
    }
#undef TILE
#undef PV_D0
#undef TRRD
#undef PK4
#undef T_DMA
    __syncthreads();
    if (hi == 0) li_l[r32] = l_reg; LDS_WAIT();
    LAS bf16_t* stg = (LAS bf16_t*)(lds + L_OST) + wid * 4096;
#pragma unroll
    for (int r = 0; r < 16; ++r) { const int orow = crow(r, hi); const float rl = __builtin_amdgcn_rcpf(li_l[orow]);
#pragma unroll
        for (int d0 = 0; d0 < 4; ++d0) { const float v = o[d0][r] * rl; const unsigned u = __float_as_uint(v); stg[orow * 128 + d0 * 32 + r32] = (bf16_t)((u + 0x7fffu + ((u >> 16) & 1u)) >> 16); } }
    LDS_WAIT();
    bf16_t* Og = a.o + (rowbase + q0 + wid * QBLK) * (size_t)NOATT + h * HD;
#pragma unroll
    for (int i = 0; i < 8; ++i) { const int row = i * 4 + (lane >> 4), ch = lane & 15; const u32x4 v = *(const LAS u32x4*)(stg + row * 128 + ch * 8); *(u32x4*)(Og + (size_t)row * NOATT + ch * 8) = v; }
    __syncthreads();
}
}

#define XB_TMO      128
#define XB_XCNT(j)  (256  + 64 * (j))
#define XB_XSUB(j)  (1280 + 64 * (j))
#define XB_XGEN(j)  (2304 + 64 * (j))
#define XB_TOP      3328
#define XB_TOPGEN   3392
#define XCD_BAR_WORDS 3456
#define XB_SPIN_CAP (1u << 22)
__device__ __forceinline__ unsigned xb_ld(unsigned* p)              { return __hip_atomic_load(p, __ATOMIC_RELAXED, __HIP_MEMORY_SCOPE_AGENT); }
__device__ __forceinline__ unsigned xb_add(unsigned* p, unsigned v) { return __hip_atomic_fetch_add(p, v, __ATOMIC_RELAXED, __HIP_MEMORY_SCOPE_AGENT); }
__device__ __forceinline__ unsigned xb_xcc_id() { return (unsigned)__builtin_amdgcn_s_getreg((3 << 11) | 20) & 0xFu; }
#define XB_SPIN(cond, bar) do { unsigned _sp = 0; while (cond) { __builtin_amdgcn_s_sleep(1); \
    if ((++_sp & 255u) == 0u) { if (xb_ld(&(bar)[XB_TMO])) break; if (_sp > XB_SPIN_CAP) { atomicAdd(&(bar)[XB_TMO], 1u); break; } } } } while (0)
struct XcdBarrier { unsigned* bar; unsigned x; volatile LAS unsigned* st; };
__device__ __forceinline__ XcdBarrier xcd_barrier_post(unsigned* bar, volatile LAS unsigned* st) {
    XcdBarrier b; b.bar = bar; b.x = xb_xcc_id(); b.st = st;
    if (threadIdx.x == 0) (void)xb_add(&bar[XB_XCNT(b.x)], 1u);
    return b;
}
__device__ __forceinline__ void xcd_barrier_complete(unsigned* bar, unsigned x, unsigned& nloc, unsigned& nx) {
    const unsigned G = gridDim.x * gridDim.y * gridDim.z;
    unsigned sum, cnt, mine, sp = 0u;
    for (;;) {
        sum = 0u; cnt = 0u; mine = 0u;
#pragma unroll
        for (unsigned j = 0; j < 16; ++j) { const unsigned c = xb_ld(&bar[XB_XCNT(j)]); sum += c; cnt += (c > 0u) ? 1u : 0u; mine = (j == x) ? c : mine; }
        if (sum == G) break;
        __builtin_amdgcn_s_sleep(1);
        if ((++sp & 255u) == 0u) { if (xb_ld(&bar[XB_TMO])) break; if (sp > XB_SPIN_CAP) { atomicAdd(&bar[XB_TMO], 1u); break; } }
    }
    nloc = mine > 0u ? mine : 1u; nx = cnt > 0u ? cnt : 1u;
}
__device__ __forceinline__ void xcd_barrier(const XcdBarrier& b, int tidx) {
    asm volatile("s_waitcnt vmcnt(0)" ::: "memory");
    __syncthreads();
    if (tidx == 0) {
        unsigned* bar = b.bar;
        __builtin_amdgcn_s_waitcnt(0);
        unsigned nloc = b.st[0], nx = b.st[1];
        if (nloc == 0u) { xcd_barrier_complete(bar, b.x, nloc, nx); b.st[0] = nloc; b.st[1] = nx; }
        const unsigned old = xb_add(&bar[XB_XSUB(b.x)], 1u);
        const unsigned gen = old / nloc;
        if (old + 1u == (gen + 1u) * nloc) {
            __builtin_amdgcn_fence(__ATOMIC_RELEASE, "agent");
            asm volatile("s_waitcnt vmcnt(0)" ::: "memory");
            const unsigned og = xb_add(&bar[XB_TOP], 1u);
            const unsigned tg = og / nx;
            if (og + 1u == (tg + 1u) * nx) xb_add(&bar[XB_TOPGEN], 1u);
            else XB_SPIN(xb_ld(&bar[XB_TOPGEN]) == tg, bar);
            __builtin_amdgcn_fence(__ATOMIC_ACQUIRE, "agent");
            xb_add(&bar[XB_XGEN(b.x)], 1u);
            asm volatile("s_waitcnt vmcnt(0)" ::: "memory");
        } else {
            XB_SPIN(xb_ld(&bar[XB_XGEN(b.x)]) == gen, bar);
            __builtin_amdgcn_fence(__ATOMIC_ACQUIRE, "agent");
            asm volatile("s_waitcnt vmcnt(0)" ::: "memory");
        }
    }
    __syncthreads();
}

struct KArgs {
    const float* x; const int* pos; const float* w_in; const float* b_forget; const float* g_q_a; const float* g_kv_a; const float* w_q_b; const float* w_kv_b;
    const float* w_br[3]; const float* w_o; const float* ln1_g; const float* ln1_b; const float* ln2_g; const float* ln2_b;
    const float* ffn_w1; const float* ffn_w3; const float* ffn_w2; const float* moe_router; const float* moe_w1; const float* moe_w3; const float* moe_w2;
    float* out; unsigned char* ws; int ph_lo, ph_hi;
};

__constant__ double ROPE_INV[32] = {1.0, 0.7498942093324559, 0.5623413251903491, 0.4216965034285822, 0.31622776601683794, 0.23713737056616552, 0.1778279410038923, 0.1333521432163324,
    0.09999999999999999, 0.07498942093324558, 0.056234132519034905, 0.042169650342858224, 0.03162277660168379, 0.023713737056616554, 0.01778279410038923, 0.013335214321633239,
    0.01, 0.007498942093324559, 0.005623413251903491, 0.004216965034285822, 0.0031622776601683794, 0.002371373705661655, 0.0017782794100389228, 0.0013335214321633238,
    0.001, 0.0007498942093324559, 0.000562341325190349, 0.00042169650342858224, 0.00031622776601683794, 0.00023713737056616554, 0.0001778279410038923, 0.0001333521432163324};

enum { MAP_ID = 0, MAP_WIN = 1, MAP_WQB = 2, MAP_WKVB = 3, MAP_GLU = 4, MAP_WING = 5 };
template <int MAPK>
__device__ __forceinline__ int src_col(int n, int& which) {
    which = 0;
    if constexpr (MAPK == MAP_ID) return n;
    if constexpr (MAPK == MAP_WIN) {
        if (n < C_CQ) return n;
        if (n < C_CKV) return SRC_CQ + (n - C_CQ);
        if (n < C_GATE) return SRC_CKV + (n - C_CKV);
        const int j = n - C_GATE;
        if (j < 64) { const int i = j >> 1; return SRC_KROPE + ((j & 1) ? 32 + i : i); }
        if (j < 72) return SRC_FORGET + (j - 64);
        return -1;
    }
    if constexpr (MAPK == MAP_WING) return SRC_GATE + n;
    if constexpr (MAPK == MAP_WQB) {
        if (n < 1024) { const int hh = n >> 7, d = n & 127; return hh * 192 + d; }
        const int j = n - 1024, hh = j >> 6, jj = j & 63, i = jj >> 1; return hh * 192 + 128 + ((jj & 1) ? 32 + i : i);
    }
    if constexpr (MAPK == MAP_WKVB) { const int hh = (n & 1023) >> 7, d = n & 127; return hh * 256 + (n >= 1024 ? 128 : 0) + d; }
    if constexpr (MAPK == MAP_GLU) { const int t = n >> 8, c = n & 255; which = (c >= 128) ? 1 : 0; return t * 128 + (c & 127); }
    return n;
}
template <int MAPK>
__device__ __forceinline__ void transpose_item(const float* W, const float* W2, const float* kscale, int K, int Nsrc, bf16_t* WT, LAS float* scr, int item, int nblk, int lane) {
    const int kb = item / nblk, nb = item % nblk, k0 = 64 * kb, n0 = 32 * nb;
    int which; const int scol = src_col<MAPK>(n0 + (lane & 31), which); const float* Ws = which ? W2 : W;
    const int scolc = scol >= 0 ? scol : 0; const float colm = scol >= 0 ? 1.f : 0.f;
    float v[32];
#pragma unroll
    for (int i = 0; i < 32; ++i) { const int kk = 2 * i + (lane >> 5); v[i] = Ws[(size_t)(k0 + kk) * Nsrc + scolc] * colm; }
#pragma unroll
    for (int i = 0; i < 32; ++i) { const int kk = 2 * i + (lane >> 5); float x = v[i]; if (kscale) x *= kscale[k0 + kk]; scr[kk * 33 + (lane & 31)] = x; }
    LDS_WAIT(); asm volatile("" ::: "memory");
    const int c = lane & 7;
#pragma unroll
    for (int j = 0; j < 4; ++j) { const int n = (lane >> 3) + 8 * j; const LAS float* s = scr + (8 * c) * 33 + n;
        u32x4 o; o.x = cvt_pk_bf16(s[0 * 33], s[1 * 33]); o.y = cvt_pk_bf16(s[2 * 33], s[3 * 33]); o.z = cvt_pk_bf16(s[4 * 33], s[5 * 33]); o.w = cvt_pk_bf16(s[6 * 33], s[7 * 33]);
        *(u32x4*)(WT + (size_t)(n0 + n) * K + k0 + 8 * c) = o; }
    LDS_WAIT(); asm volatile("" ::: "memory");
}
template <int MAPK>
__device__ __forceinline__ void transpose_item_f8(const float* W, const float* W2, float wscale, int K, int Nsrc, unsigned char* WT, LAS float* scr, int item, int nblk, int lane) {
    const int kb = item / nblk, nb = item % nblk, k0 = 64 * kb, n0 = 32 * nb;
    int which; const int scol = src_col<MAPK>(n0 + (lane & 31), which); const float* Ws = which ? W2 : W;
    const int scolc = scol >= 0 ? scol : 0; const float colm = scol >= 0 ? 1.f : 0.f;
    float v[32];
#pragma unroll
    for (int i = 0; i < 32; ++i) { const int kk = 2 * i + (lane >> 5); v[i] = Ws[(size_t)(k0 + kk) * Nsrc + scolc] * colm; }
#pragma unroll
    for (int i = 0; i < 32; ++i) { const int kk = 2 * i + (lane >> 5); scr[kk * 33 + (lane & 31)] = v[i] * wscale; }
    LDS_WAIT(); asm volatile("" ::: "memory");
    const int c = lane & 3;
#pragma unroll
    for (int j = 0; j < 2; ++j) { const int n = (lane >> 2) + 16 * j; const LAS float* sp = scr + (16 * c) * 33 + n;
        u32x4 o; o.x = pk4_fp8(sp[0 * 33], sp[1 * 33], sp[2 * 33], sp[3 * 33]); o.y = pk4_fp8(sp[4 * 33], sp[5 * 33], sp[6 * 33], sp[7 * 33]);
        o.z = pk4_fp8(sp[8 * 33], sp[9 * 33], sp[10 * 33], sp[11 * 33]); o.w = pk4_fp8(sp[12 * 33], sp[13 * 33], sp[14 * 33], sp[15 * 33]);
        *(u32x4*)(WT + (size_t)(n0 + n) * K + k0 + 16 * c) = o; }
    LDS_WAIT(); asm volatile("" ::: "memory");
}
template <int MAPK>
__device__ __forceinline__ void transpose_matrix_f8(const float* W, const float* W2, float wscale, int K, int Nsrc, int Ndst, unsigned char* WT, LAS float* scr, int gw, int NGW, int lane) {
    const int nblk = Ndst / 32, nitems = (K / 64) * nblk;
    for (int it = gw; it < nitems; it += NGW) transpose_item_f8<MAPK>(W, W2, wscale, K, Nsrc, WT, scr, it, nblk, lane);
}
template <int MAPK>
__device__ __forceinline__ void transpose_matrix(const float* W, const float* W2, const float* kscale, int K, int Nsrc, int Ndst, bf16_t* WT, LAS float* scr, int gw, int NGW, int lane) {
    const int nblk = Ndst / 32, nitems = (K / 64) * nblk;
    for (int it = gw; it < nitems; it += NGW) transpose_item<MAPK>(W, W2, kscale, K, Nsrc, WT, scr, it, nblk, lane);
}

#define LNC(j) (2 * (lane + 64 * ((j) >> 1)) + ((j) & 1))
__device__ __forceinline__ void ln_row(f32x4 (&v)[8], const float* g, const float* bta, int lane) {
    float s = 0.f;
#pragma unroll
    for (int j = 0; j < 8; ++j) s += (v[j][0] + v[j][1]) + (v[j][2] + v[j][3]);
    const float mean = wave_sum(s) * (1.f / DM); float s2 = 0.f;
#pragma unroll
    for (int j = 0; j < 8; ++j) { v[j] = v[j] - mean; s2 += (v[j][0] * v[j][0] + v[j][1] * v[j][1]) + (v[j][2] * v[j][2] + v[j][3] * v[j][3]); }
    const float rstd = 1.f / sqrtf(wave_sum(s2) * (1.f / DM) + LN_EPS);
#pragma unroll
    for (int j = 0; j < 8; ++j) { const f32x4 gg = *(const f32x4*)(g + 4 * LNC(j)), bb = *(const f32x4*)(bta + 4 * LNC(j)); v[j] = v[j] * rstd * gg + bb; }
}

__device__ __forceinline__ bool ph_in(int lo, int hi, int k) { asm volatile("" : "+s"(lo), "+s"(hi)); return lo <= k && k < hi; }
#define PHASE_PTRS() GAS unsigned char* ws0_ = (GAS unsigned char*)args.ws; asm volatile("" : "+s"(ws0_)); unsigned char* ws = (unsigned char*)ws0_;     \
    unsigned* ctl = (unsigned*)(ws + WS_CTL); (void)ctl; \
    int bx = blockIdx.x, G = gridDim.x; asm volatile("" : "+s"(bx), "+s"(G)); const int vcu = (G % 8 == 0) ? (bx % 8) * (G / 8) + bx / 8 : bx; const int NGW = G * NWAVES; (void)vcu; (void)NGW; \
    float* cosT = (float*)(ws + WS_COS); float* sinT = (float*)(ws + WS_SIN); float* ssq = (float*)(ws + WS_SSQ); float* lf = (float*)(ws + WS_LF); float* cb = (float*)(ws + WS_CB); \
    bf16_t* kmh = (bf16_t*)(ws + WS_KMH); bf16_t* kml = (bf16_t*)(ws + WS_KML); bf16_t* kpe = (bf16_t*)(ws + WS_KPE); \
    int* ltok = (int*)(ws + WS_LTOK); int* ldst = (int*)(ws + WS_LDST); float* lgate = (float*)(ws + WS_LGATE); \
    bf16_t* XB = (bf16_t*)(ws + WS_XB); bf16_t* X1 = (bf16_t*)(ws + WS_X1); bf16_t* PROJ = (bf16_t*)(ws + WS_PROJ); bf16_t* QM = (bf16_t*)(ws + WS_QM); bf16_t* KVM = (bf16_t*)(ws + WS_KVM); \
    bf16_t* OATT = (bf16_t*)(ws + WS_OATT); bf16_t* MERGED = (bf16_t*)(ws + WS_MERGED); bf16_t* Y = (bf16_t*)(ws + WS_Y); bf16_t* HID = (bf16_t*)(ws + WS_HID); bf16_t* YMOE = (bf16_t*)(ws + WS_YMOE); unsigned char* XGFR = ws + WS_XGFR; \
    (void)cosT; (void)sinT; (void)ssq; (void)lf; (void)cb; (void)kmh; (void)kml; (void)kpe; (void)ltok; (void)ldst; (void)lgate; (void)XB; (void)X1; (void)PROJ; (void)QM; (void)KVM; (void)OATT; (void)MERGED; (void)Y; (void)HID; (void)YMOE; (void)XGFR;
#define MOE_COUNTS() int cnt[8], tb[9]; tb[0] = 0; \
    _Pragma("unroll") for (int e = 0; e < 8; ++e) { cnt[e] = __builtin_amdgcn_readfirstlane((int)__hip_atomic_load(ctl + CW_CNT + e, RLX_AGENT)); if (cnt[e] > MTOK) cnt[e] = MTOK; tb[e + 1] = tb[e] + ((cnt[e] + 255) >> 8); }
#define OPAQUE_IDS() int tid = my_tid(wave0); const int lane = tid & 63, wave = __builtin_amdgcn_readfirstlane(tid >> 6); const int gw = vcu * NWAVES + wave; (void)lane; (void)gw;
constexpr int PH_PER_LAYER = 10, N_PHASES = 1 + 2 * PH_PER_LAYER;
#define IN(k) ph_in(lo, hi, (k))
#define SEAM(k) do { if (IN(k) && IN((k) + 1)) { XcdBarrier b_; b_.bar = (unsigned*)(args.ws + WS_CTL) + CW_BAR; b_.x = xb_xcc_id(); b_.st = MISC + 8; xcd_barrier(b_, my_tid(wave0)); } } while (0)
struct LArgs { const float* b_forget; const float* ln1_g; const float* ln1_b; const float* ln2_g; const float* ln2_b; const float* moe_router; float* out; unsigned char* ws; };
template <int l>
__device__ __forceinline__ void layer_fn(const LArgs args, LAS unsigned char* ldsL, volatile LAS unsigned* MISC, const int wave0, const int lo, const int hi) {
        const int P = 1 + l * PH_PER_LAYER;
        for (int rep_ = 0; rep_ < NREP(0); ++rep_) if (IN(P + 0) && EN(0)) {
            PHASE_PTRS();
            pg8::Shape g{DM, DM, DM};
            SchedPlain S{64, 29, G, bx, (unsigned)WS_XB, (unsigned)(WS_WIN + (size_t)l * NWIN16 * DM * 2), 256u * DM * 2, 256u * DM * 2};
            EpiInProj E{PROJ, ssq, cosT, sinT, kpe, lf, args.b_forget + l * 8};
            pg8::gemm_phase(ldsL, (const char*)ws, wave0, g, S, E);
            pg8::Shape g8{DM / 2, DM / 2, DM / 2};
            SchedGates S8{G, bx, (unsigned)WS_XBF, (unsigned)(WS_WINF + (size_t)l * 6144 * DM)};
            EpiGates8 E8{PROJ};
            pg8::gemm_phase<EpiGates8, SchedGates, true>(ldsL, (const char*)ws, wave0, g8, S8, E8);
        }
        SEAM(P + 0);
        for (int rep_ = 0; rep_ < NREP(1); ++rep_) if (IN(P + 1) && EN(1)) {
            PHASE_PTRS();
            { OPAQUE_IDS();
            if (gw < 32) {
                const int b = gw >> 3, h = gw & 7; float carry = 0.f;
                for (int j = 0; j < 64; ++j) { const int s = j * 64 + lane; float v = lf[((size_t)b * SEQ + s) * 8 + h];
#pragma unroll
                    for (int o = 1; o < 64; o <<= 1) { const float t = __int_as_float(__builtin_amdgcn_ds_bpermute(((lane - o) & 63) << 2, __float_as_int(v))); if (lane >= o) v += t; }
                    cb[(size_t)gw * SEQ + s] = -(carry + v) * LOG2E; carry += __int_as_float(__builtin_amdgcn_readlane(__float_as_int(v), 63)); }
            } else if (gw < 32 + 512) {
                const int it = gw - 32, bh = it >> 4, n = it & 15, b = bh >> 3, h = bh & 7;
                const bf16_t* kp = PROJ + ((size_t)b * SEQ + n * 256) * NPROJ + C_MOBA + 1024 + h * HD + 2 * lane; float s0 = 0.f, s1 = 0.f;
#pragma unroll 16
                for (int r = 0; r < 256; ++r) { const unsigned w = *(const unsigned*)(kp + (size_t)r * NPROJ); s0 += bf_lo(w); s1 += bf_hi(w); }
                s0 *= (1.f / 256.f); s1 *= (1.f / 256.f);
                const unsigned hw = cvt_pk_bf16(s0, s1); const unsigned lw = cvt_pk_bf16(s0 - bf_lo(hw), s1 - bf_hi(hw));
                *(unsigned*)(kmh + (size_t)it * HD + 2 * lane) = hw; *(unsigned*)(kml + (size_t)it * HD + 2 * lane) = lw;
            } }
            __syncthreads();
            pg8::Shape g{QLORA, NPROJ, QLORA};
            SchedMlaUp S{G, bx, (unsigned)(WS_PROJ + C_CQ * 2), (unsigned)(WS_PROJ + C_CKV * 2), (unsigned)(WS_WQB + (size_t)l * NQM * QLORA * 2), (unsigned)(WS_WKVB + (size_t)l * NKVM * QLORA * 2)};
            EpiMlaUp E{QM, KVM, ssq, cosT, sinT};
            pg8::gemm_phase(ldsL, (const char*)ws, wave0, g, S, E);
        }
        SEAM(P + 1);
        for (int rep_ = 0; rep_ < NREP(2); ++rep_) if (IN(P + 2) && EN(2)) {
            PHASE_PTRS();
            for (int it = vcu; it < 256; it += G) { const int bh = it >> 3, s = it & 7, b = bh >> 3, h = bh & 7;
                if (ATT_MODES & 1) { att::Args a{PROJ + C_MOBA, NPROJ, nullptr, PROJ + C_MOBA + 1024, NPROJ, nullptr, PROJ + C_MOBA + 2048, NPROJ, OATT, nullptr, kmh, kml};
                  for (int ps = 0; ps < 2; ++ps) att::attn_unit<att::MOBA>(a, b, h, ps ? 15 - s : s, ldsL, wave0); }
                if (ATT_MODES & 2) { att::Args a{PROJ + C_FOX, NPROJ, nullptr, PROJ + C_FOX + 1024, NPROJ, nullptr, PROJ + C_FOX + 2048, NPROJ, OATT + 1024, cb, nullptr, nullptr};
                  for (int ps = 0; ps < 2; ++ps) att::attn_unit<att::FOX>(a, b, h, ps ? 15 - s : s, ldsL, wave0); }
                if (ATT_MODES & 4) { att::Args a{QM, NQM, QM + 1024, KVM, NKVM, kpe, KVM + 1024, NKVM, OATT + 2048, nullptr, nullptr, nullptr};
                  for (int ps = 0; ps < 2; ++ps) att::attn_unit<att::MLA>(a, b, h, ps ? 15 - s : s, ldsL, wave0); }
            }
        }
        SEAM(P + 2);
        for (int rep_ = 0; rep_ < NREP(3); ++rep_) if (IN(P + 3) && EN(3)) {
            PHASE_PTRS();
            pg8::Shape g{1024, NOATT, 1024};
            SchedMerge S{G, bx, (unsigned)WS_OATT, (unsigned)(WS_WBR + (size_t)l * 3 * DM * 1024 * 2)};
            EpiGateMerge E{PROJ, MERGED};
            pg8::gemm_phase(ldsL, (const char*)ws, wave0, g, S, E);
        }
        SEAM(P + 3);
        for (int rep_ = 0; rep_ < NREP(4); ++rep_) if (IN(P + 4) && EN(4)) {
            PHASE_PTRS();
            pg8::Shape g{DM, DM, DM};
            SchedPlain S{64, 8, G, bx, (unsigned)WS_MERGED, (unsigned)(WS_WO + (size_t)l * DM * DM * 2), 256u * DM * 2, 256u * DM * 2};
            EpiResidual E{XB, Y};
            pg8::gemm_phase(ldsL, (const char*)ws, wave0, g, S, E);
        }
        SEAM(P + 4);
        if (IN(P + 5) && EN(5)) {
            PHASE_PTRS(); OPAQUE_IDS();
            const float* g1 = args.ln1_g + l * DM; const float* b1 = args.ln1_b + l * DM;
            if (l == 0) {
                for (int m = gw; m < MTOK; m += NGW) { f32x4 v[8]; const u32x4* yr = (const u32x4*)(Y + (size_t)m * DM);
#pragma unroll
                    for (int jj = 0; jj < 4; ++jj) unpack8(yr[lane + 64 * jj], v[2 * jj], v[2 * jj + 1]);
                    ln_row(v, g1, b1, lane); u32x4* o16 = (u32x4*)(X1 + (size_t)m * DM);
#pragma unroll
                    for (int jj = 0; jj < 4; ++jj) o16[lane + 64 * jj] = pack8(v[2 * jj], v[2 * jj + 1]); }
            } else {
                LAS float* wrT = (LAS float*)ldsL; LAS int* selE = (LAS int*)(ldsL + 65536); LAS float* selG = (LAS float*)(ldsL + 65536 + 1024); LAS int* dstR = (LAS int*)(ldsL + 65536 + 2048);
                for (int u = tid; u < DM * NEXP; u += NWAVES * 64) { const int d = u >> 3, e = u & 7; wrT[e * DM + d] = args.moe_router[u]; }
                __syncthreads();
                for (int c0 = vcu * 64; c0 < MTOK; c0 += G * 64) {
                    for (int i = 0; i < 8; ++i) { const int tl = wave * 8 + i, m = c0 + tl; f32x4 v[8]; const u32x4* yr = (const u32x4*)(Y + (size_t)m * DM);
#pragma unroll
                        for (int jj = 0; jj < 4; ++jj) unpack8(yr[lane + 64 * jj], v[2 * jj], v[2 * jj + 1]);
                        ln_row(v, g1, b1, lane); u32x4* o16 = (u32x4*)(X1 + (size_t)m * DM);
#pragma unroll
                        for (int jj = 0; jj < 4; ++jj) o16[lane + 64 * jj] = pack8(v[2 * jj], v[2 * jj + 1]);
                        float lg[8];
#pragma unroll
                        for (int e = 0; e < 8; ++e) { float s = 0.f;
#pragma unroll
                            for (int j = 0; j < 8; ++j) { const f32x4 w = *(const LAS f32x4*)(wrT + e * DM + 4 * LNC(j)); s += (v[j][0] * w[0] + v[j][1] * w[1]) + (v[j][2] * w[2] + v[j][3] * w[3]); }
                            lg[e] = wave_sum(s); }
                        int e0 = 0; float v0 = lg[0];
#pragma unroll
                        for (int e = 1; e < 8; ++e) if (lg[e] > v0) { v0 = lg[e]; e0 = e; }
                        int e1 = -1; float v1 = -__builtin_inff();
#pragma unroll
                        for (int e = 0; e < 8; ++e) if (e != e0 && lg[e] > v1) { v1 = lg[e]; e1 = e; }
                        const float g0 = 1.0f / (1.0f + expf(v1 - v0));
                        if (lane == 0) { selE[tl * 2] = e0; selE[tl * 2 + 1] = e1; selG[tl * 2] = g0; selG[tl * 2 + 1] = 1.0f - g0; } }
                    __syncthreads();
                    if (wave == 0) { const int e0 = selE[lane * 2], e1 = selE[lane * 2 + 1]; int r0 = 0, r1 = 0, mycnt = 0;
                        const unsigned long long lt = (1ull << lane) - 1ull;
#pragma unroll
                        for (int e = 0; e < 8; ++e) { const unsigned long long m0 = __ballot(e0 == e), m1 = __ballot(e1 == e); const int c0e = __popcll(m0);
                            if (e0 == e) r0 = __popcll(m0 & lt); if (e1 == e) r1 = c0e + __popcll(m1 & lt); if (lane == e) mycnt = c0e + __popcll(m1); }
                        int mybase = 0; if (lane < 8) mybase = (int)atomicAdd(ctl + CW_CNT + lane, (unsigned)mycnt);
                        const int b0 = __builtin_amdgcn_ds_bpermute(e0 << 2, mybase), b1 = __builtin_amdgcn_ds_bpermute(e1 << 2, mybase); const int m = c0 + lane;
                        const int p0 = b0 + r0, p1 = b1 + r1;
                        ltok[e0 * MTOK + p0] = m; ldst[e0 * MTOK + p0] = 2 * m; lgate[e0 * MTOK + p0] = selG[lane * 2];
                        ltok[e1 * MTOK + p1] = m; ldst[e1 * MTOK + p1] = 2 * m + 1; lgate[e1 * MTOK + p1] = selG[lane * 2 + 1];
                        dstR[lane * 2] = e0 * MTOK + p0; dstR[lane * 2 + 1] = e1 * MTOK + p1; }
                    __syncthreads();
                    for (int i = 0; i < 8; ++i) { const int tl = wave * 8 + i, m = c0 + tl; const u32x4* xr = (const u32x4*)(X1 + (size_t)m * DM);
                        const int d0 = __builtin_amdgcn_readfirstlane(dstR[tl * 2]), d1 = __builtin_amdgcn_readfirstlane(dstR[tl * 2 + 1]);
                        u32x2* o0 = (u32x2*)(XGFR + (size_t)d0 * DM); u32x2* o1 = (u32x2*)(XGFR + (size_t)d1 * DM);
#pragma unroll
                        for (int jj = 0; jj < 4; ++jj) { f32x4 a0, a1; unpack8(xr[lane + 64 * jj], a0, a1); u32x2 w;
                            w.x = pk4_fp8(a0[0] * X_SCALE, a0[1] * X_SCALE, a0[2] * X_SCALE, a0[3] * X_SCALE); w.y = pk4_fp8(a1[0] * X_SCALE, a1[1] * X_SCALE, a1[2] * X_SCALE, a1[3] * X_SCALE);
                            o0[lane + 64 * jj] = w; o1[lane + 64 * jj] = w; } }
                    __syncthreads();
                }
            }
        }
        SEAM(P + 5);
        for (int rep_ = 0; rep_ < NREP(7); ++rep_) if (IN(P + 7) && EN(7)) {
            PHASE_PTRS();
            if (l == 0) {
                pg8::Shape g{DM, DM, DM};
                SchedPlain S{64, 2 * DFF / 256, G, bx, (unsigned)WS_X1, (unsigned)WS_WF13, 256u * DM * 2, 256u * DM * 2};
                EpiSwiGLU E{HID, DFF};
                pg8::gemm_phase(ldsL, (const char*)ws, wave0, g, S, E);
            } else {
                MOE_COUNTS();
                pg8::Shape g{DM / 2, DM / 2, DM / 2};
                SchedMoe S; S.nM = tb[8]; S.nN = 2 * DFFE / 256; S.G = G; S.c = bx; S.A = (unsigned)WS_XGFR; S.regA = 1; S.B = (unsigned)WS_WM13; S.tA = 256u * DM; S.tB = 256u * DM; S.eB = 2u * DFFE * DM;
                S.tbp = (unsigned long long)((unsigned)tb[1] | ((unsigned)tb[2] << 8) | ((unsigned)tb[3] << 16) | ((unsigned)tb[4] << 24)) | ((unsigned long long)((unsigned)tb[5] | ((unsigned)tb[6] << 8) | ((unsigned)tb[7] << 16) | ((unsigned)tb[8] << 24)) << 32);
                EpiSwiGLU8 E{(unsigned char*)HID, DFFE};
                pg8::gemm_phase<EpiSwiGLU8, SchedMoe, true>(ldsL, (const char*)ws, wave0, g, S, E);
            }
        }
        SEAM(P + 7);
        for (int rep_ = 0; rep_ < NREP(8); ++rep_) if (IN(P + 8) && EN(8)) {
            PHASE_PTRS();
            if (l == 0) {
                pg8::Shape g{DFF, DFF, DFF};
                SchedPlain S{64, 8, G, bx, (unsigned)WS_HID, (unsigned)WS_WF2, 256u * DFF * 2, 256u * DFF * 2};
                EpiResidual E{X1, Y};
                pg8::gemm_phase(ldsL, (const char*)ws, wave0, g, S, E);
            } else {
                MOE_COUNTS();
                pg8::Shape g{DFFE / 2, DFFE / 2, DFFE / 2};
                SchedMoe S; S.nM = tb[8]; S.nN = 8; S.G = G; S.c = bx; S.A = (unsigned)WS_HID; S.regA = 0; S.B = (unsigned)WS_WM2; S.tA = 256u * DFFE; S.tB = 256u * DFFE; S.eB = (unsigned)DM * DFFE;
                S.tbp = (unsigned long long)((unsigned)tb[1] | ((unsigned)tb[2] << 8) | ((unsigned)tb[3] << 16) | ((unsigned)tb[4] << 24)) | ((unsigned long long)((unsigned)tb[5] | ((unsigned)tb[6] << 8) | ((unsigned)tb[7] << 16) | ((unsigned)tb[8] << 24)) << 32);
                EpiMoeDown E; E.ymoe = YMOE; E.ldst = ldst; E.lgate = lgate;
                E.tbp = (unsigned long long)((unsigned)tb[0] | ((unsigned)tb[1] << 8) | ((unsigned)tb[2] << 16) | ((unsigned)tb[3] << 24)) | ((unsigned long long)((unsigned)tb[4] | ((unsigned)tb[5] << 8) | ((unsigned)tb[6] << 16) | ((unsigned)tb[7] << 24)) << 32);
                E.cntp = ctl + CW_CNT;
                pg8::gemm_phase<EpiMoeDown, SchedMoe, true>(ldsL, (const char*)ws, wave0, g, S, E);
            }
        }
        SEAM(P + 8);
        for (int rep_ = 0; rep_ < NREP(9); ++rep_) if (IN(P + 9) && EN(9)) {
            PHASE_PTRS(); OPAQUE_IDS();
            const float* g2 = args.ln2_g + l * DM; const float* b2 = args.ln2_b + l * DM;
            for (int m = gw; m < MTOK; m += NGW) { f32x4 v[8];
                if (l == 0) { const u32x4* yr = (const u32x4*)(Y + (size_t)m * DM);
#pragma unroll
                    for (int jj = 0; jj < 4; ++jj) unpack8(yr[lane + 64 * jj], v[2 * jj], v[2 * jj + 1]);
                } else { const u32x4* xr = (const u32x4*)(X1 + (size_t)m * DM); const u32x4* y0 = (const u32x4*)(YMOE + (size_t)(2 * m) * DM); const u32x4* y1 = (const u32x4*)(YMOE + (size_t)(2 * m + 1) * DM);
#pragma unroll
                    for (int jj = 0; jj < 4; ++jj) { f32x4 a0, a1, p0, p1, q0, q1; unpack8(xr[lane + 64 * jj], a0, a1); unpack8(y0[lane + 64 * jj], p0, p1); unpack8(y1[lane + 64 * jj], q0, q1);
                        v[2 * jj] = a0 * ALPHA + p0 + q0; v[2 * jj + 1] = a1 * ALPHA + p1 + q1; } }
                ln_row(v, g2, b2, lane);
                if (l == 0) { u32x4* o16 = (u32x4*)(XB + (size_t)m * DM); u32x2* o8 = (u32x2*)(ws + WS_XBF + (size_t)m * DM);
#pragma unroll
                    for (int jj = 0; jj < 4; ++jj) { o16[lane + 64 * jj] = pack8(v[2 * jj], v[2 * jj + 1]);
                        u32x2 w; w.x = pk4_fp8(v[2 * jj][0] * X_SCALE, v[2 * jj][1] * X_SCALE, v[2 * jj][2] * X_SCALE, v[2 * jj][3] * X_SCALE);
                        w.y = pk4_fp8(v[2 * jj + 1][0] * X_SCALE, v[2 * jj + 1][1] * X_SCALE, v[2 * jj + 1][2] * X_SCALE, v[2 * jj + 1][3] * X_SCALE); o8[lane + 64 * jj] = w; }
                } else { f32x4* o = (f32x4*)(args.out + (size_t)m * DM);
#pragma unroll
                    for (int j = 0; j < 8; ++j) o[LNC(j)] = v[j]; } }
        }
        if (l == 0) SEAM(P + 9);
        }

__global__ void __launch_bounds__(NWAVES * 64, 2) hyb_fwd(KArgs args) {
    extern __shared__ __attribute__((aligned(16))) unsigned char lds[];
    LAS unsigned char* ldsL = (LAS unsigned char*)lds;
    volatile LAS unsigned* MISC = (volatile LAS unsigned*)(ldsL + MISC_OFF);
    const int tid0 = threadIdx.x; const int wave0 = __builtin_amdgcn_readfirstlane(tid0 >> 6);
    unsigned char* ws = args.ws;
    unsigned* ctl = (unsigned*)(ws + WS_CTL);
    for (int u = tid0; u < (LDS_BYTES - RING_BYTES) / 4; u += NWAVES * 64) ((LAS unsigned*)(ldsL + RING_BYTES))[u] = 0u;
    __syncthreads();
    if (MK_N_LAUNCHES == 1) (void)xcd_barrier_post(ctl + CW_BAR, MISC + 8);
    const int lo = args.ph_lo, hi = args.ph_hi;
    for (int rep_ = 0; rep_ < NREP(10); ++rep_) if (IN(0) && EN(10)) {
        PHASE_PTRS(); OPAQUE_IDS();
        LAS float* scr = (LAS float*)(ldsL + wave * 16384);
        for (int l = 0; l < 2; ++l) {
            transpose_matrix<MAP_WIN>(args.w_in + (size_t)l * DM * SRC_NPROJ, nullptr, nullptr, DM, SRC_NPROJ, NWIN16, (bf16_t*)(ws + WS_WIN) + (size_t)l * NWIN16 * DM, scr, gw, NGW, lane);
            transpose_matrix_f8<MAP_WING>(args.w_in + (size_t)l * DM * SRC_NPROJ, nullptr, W13_SCALE, DM, SRC_NPROJ, 6144, ws + WS_WINF + (size_t)l * 6144 * DM, scr, gw, NGW, lane);
            transpose_matrix<MAP_WQB>(args.w_q_b + (size_t)l * QLORA * NQM, nullptr, args.g_q_a + l * QLORA, QLORA, NQM, NQM, (bf16_t*)(ws + WS_WQB) + (size_t)l * NQM * QLORA, scr, gw, NGW, lane);
            transpose_matrix<MAP_WKVB>(args.w_kv_b + (size_t)l * QLORA * NKVM, nullptr, args.g_kv_a + l * QLORA, QLORA, NKVM, NKVM, (bf16_t*)(ws + WS_WKVB) + (size_t)l * NKVM * QLORA, scr, gw, NGW, lane);
            for (int br = 0; br < 3; ++br)
                transpose_matrix<MAP_ID>(args.w_br[br] + (size_t)l * 1024 * DM, nullptr, nullptr, 1024, DM, DM, (bf16_t*)(ws + WS_WBR) + ((size_t)l * 3 + br) * DM * 1024, scr, gw, NGW, lane);
            transpose_matrix<MAP_ID>(args.w_o + (size_t)l * DM * DM, nullptr, nullptr, DM, DM, DM, (bf16_t*)(ws + WS_WO) + (size_t)l * DM * DM, scr, gw, NGW, lane);
        }
        transpose_matrix<MAP_GLU>(args.ffn_w1, args.ffn_w3, nullptr, DM, DFF, 2 * DFF, (bf16_t*)(ws + WS_WF13), scr, gw, NGW, lane);
        transpose_matrix<MAP_ID>(args.ffn_w2, nullptr, nullptr, DFF, DM, DM, (bf16_t*)(ws + WS_WF2), scr, gw, NGW, lane);
        for (int e = 0; e < NEXP; ++e) {
            transpose_matrix_f8<MAP_GLU>(args.moe_w1 + (size_t)e * DM * DFFE, args.moe_w3 + (size_t)e * DM * DFFE, W13_SCALE, DM, DFFE, 2 * DFFE, ws + WS_WM13 + (size_t)e * 2 * DFFE * DM, scr, gw, NGW, lane);
            transpose_matrix_f8<MAP_ID>(args.moe_w2 + (size_t)e * DFFE * DM, nullptr, W2_SCALE, DFFE, DM, DM, ws + WS_WM2 + (size_t)e * DM * DFFE, scr, gw, NGW, lane);
        }
        for (int m = gw; m < MTOK; m += NGW) { const f32x4* xr = (const f32x4*)(args.x + (size_t)m * DM); u32x2* o8 = (u32x2*)(XB + (size_t)m * DM);
#pragma unroll
            for (int j = 0; j < 8; ++j) { const f32x4 v = xr[lane + 64 * j]; u32x2 w; w.x = cvt_pk_bf16(v[0], v[1]); w.y = cvt_pk_bf16(v[2], v[3]); o8[lane + 64 * j] = w;
                ((unsigned*)(ws + WS_XBF + (size_t)m * DM))[lane + 64 * j] = pk4_fp8(v[0] * X_SCALE, v[1] * X_SCALE, v[2] * X_SCALE, v[3] * X_SCALE); } }
        for (int idx = bx * (NWAVES * 64) + tid; idx < MTOK * 32; idx += G * NWAVES * 64) { const int m = idx >> 5, i = idx & 31;
            const double ang = (double)args.pos[m] * ROPE_INV[i]; const double t = ang * 0.15915494309189535; const double fr = t - floor(t);
            const double x4 = fr * 4.0; const int oct = (int)x4; const double r = (x4 - (double)oct) * 1.5707963267948966;
            const double rr = r - 0.7853981633974483, r2 = rr * rr;
            double sn = rr * (1.0 + r2 * (-1.0 / 6 + r2 * (1.0 / 120 + r2 * (-1.0 / 5040 + r2 * (1.0 / 362880 + r2 * (-1.0 / 39916800 + r2 * (1.0 / 6227020800.0)))))));
            double cs = 1.0 + r2 * (-0.5 + r2 * (1.0 / 24 + r2 * (-1.0 / 720 + r2 * (1.0 / 40320 + r2 * (-1.0 / 3628800 + r2 * (1.0 / 479001600.0 + r2 * (-1.0 / 87178291200.0)))))));
            const double h = 0.7071067811865476; const double s1 = h * (sn + cs), c1 = h * (cs - sn);
            double so, co; if (oct == 0) { so = s1; co = c1; } else if (oct == 1) { so = c1; co = -s1; } else if (oct == 2) { so = -s1; co = -c1; } else { so = -c1; co = s1; }
            cosT[idx] = (float)co; sinT[idx] = (float)so; }
        if (bx == 0) { for (int u = tid; u < DM / 2; u += NWAVES * 64) { ((unsigned*)(XB + (size_t)MTOK * DM))[u] = 0u; ((unsigned*)(X1 + (size_t)MTOK * DM))[u] = 0u; } }
    }
    SEAM(0);

    const LArgs la{args.b_forget, args.ln1_g, args.ln1_b, args.ln2_g, args.ln2_b, args.moe_router, args.out, args.ws};
    layer_fn<0>(la, ldsL, MISC, wave0, lo, hi);
    layer_fn<1>(la, ldsL, MISC, wave0, lo, hi);
#undef IN
#undef SEAM
}

extern "C" void kernel_launch(void* const* d_in, const int* in_sizes, int n_in, void* d_out, int out_size, void* d_ws, size_t ws_size, hipStream_t stream) {
    static int grid = 0;
    if (grid == 0) {
        if (n_in != 23 || ws_size < WS_END) { fprintf(stderr, "kernel_launch: need 23 inputs and >= %zu bytes of workspace; got %d, %zu\n", (size_t)WS_END, n_in, ws_size); grid = -1; return; }
        int dev = 0, cus = 0;
        if (hipGetDevice(&dev) != hipSuccess || hipDeviceGetAttribute(&cus, hipDeviceAttributeMultiprocessorCount, dev) != hipSuccess) { grid = -1; return; }
        if (hipFuncSetAttribute((const void*)hyb_fwd, hipFuncAttributeMaxDynamicSharedMemorySize, LDS_BYTES) != hipSuccess) { fprintf(stderr, "kernel_launch: hipFuncSetAttribute failed\n"); grid = -1; return; }
        int per_cu = 0;
        if (hipOccupancyMaxActiveBlocksPerMultiprocessor(&per_cu, (const void*)hyb_fwd, NWAVES * 64, LDS_BYTES) != hipSuccess || per_cu < 1) { fprintf(stderr, "kernel_launch: occupancy query says %d\n", per_cu); }
        (void)hipGetLastError();
        grid = cus;
    }
    if (grid < 0) return;
    (void)hipMemsetAsync((char*)d_ws + WS_CTL, 0, CTL_ZERO_BYTES, stream);
    KArgs a{};
    a.x = (const float*)d_in[0]; a.pos = (const int*)d_in[1]; a.w_in = (const float*)d_in[2]; a.b_forget = (const float*)d_in[3]; a.g_q_a = (const float*)d_in[4]; a.g_kv_a = (const float*)d_in[5];
    a.w_q_b = (const float*)d_in[6]; a.w_kv_b = (const float*)d_in[7]; a.w_br[0] = (const float*)d_in[8]; a.w_br[1] = (const float*)d_in[9]; a.w_br[2] = (const float*)d_in[10]; a.w_o = (const float*)d_in[11];
    a.ln1_g = (const float*)d_in[12]; a.ln1_b = (const float*)d_in[13]; a.ln2_g = (const float*)d_in[14]; a.ln2_b = (const float*)d_in[15];
    a.ffn_w1 = (const float*)d_in[16]; a.ffn_w3 = (const float*)d_in[17]; a.ffn_w2 = (const float*)d_in[18]; a.moe_router = (const float*)d_in[19]; a.moe_w1 = (const float*)d_in[20]; a.moe_w3 = (const float*)d_in[21]; a.moe_w2 = (const float*)d_in[22];
    a.out = (float*)d_out; a.ws = (unsigned char*)d_ws;
#if MK_N_LAUNCHES == 1
    a.ph_lo = 0; a.ph_hi = N_PHASES;
    hipLaunchKernelGGL(hyb_fwd, dim3(grid), dim3(NWAVES * 64), LDS_BYTES, stream, a);
#else
    for (int p = 0; p < N_PHASES; ++p) { if (p == 7) continue; a.ph_lo = p; a.ph_hi = p + 1; hipLaunchKernelGGL(hyb_fwd, dim3(grid), dim3(NWAVES * 64), LDS_BYTES, stream, a); }
#endif
}
```

```cpp
#include <hip/hip_runtime.h>
#include <cstdio>
#include <cstdint>
#include <type_traits>

#ifndef MK_N_LAUNCHES
#define MK_N_LAUNCHES 1
#endif
#ifndef PH_ENABLE
#define PH_ENABLE 0xFFFF
#endif
#define EN(k) (((PH_ENABLE) >> (k)) & 1)
#ifndef PROBE_REPEAT
#define PROBE_REPEAT 0
#endif
#define NREP(k) ((((PROBE_REPEAT) >> (k)) & 1) ? 2 : 1)
#ifndef ATT_MODES
#define ATT_MODES 7
#endif

#define GAS __attribute__((address_space(1)))
#define LAS __attribute__((address_space(3)))
typedef unsigned short bf16_t;
typedef short bf16x8 __attribute__((ext_vector_type(8)));
typedef short s16x4 __attribute__((ext_vector_type(4)));
typedef float f32x4 __attribute__((ext_vector_type(4)));
typedef float f32x2 __attribute__((ext_vector_type(2)));
typedef float f32x16 __attribute__((ext_vector_type(16)));
typedef unsigned u32x4 __attribute__((ext_vector_type(4)));
typedef unsigned u32x2 __attribute__((ext_vector_type(2)));

constexpr int NBATCH = 4, SEQ = 4096, DM = 2048, MTOK = NBATCH * SEQ, NHEAD = 8, HD = 128;
constexpr int NPROJ = 13568;
constexpr int C_MOBA = 0, C_FOX = 3072, C_CQ = 6144, C_CKV = 6656, C_GATE = 7168, C_SPEC = 13312;
constexpr int SRC_FORGET = 6144, SRC_CQ = 6152, SRC_CKV = 6664, SRC_KROPE = 7176, SRC_GATE = 7240, SRC_NPROJ = 13384;
constexpr int QLORA = 512, NQM = 1536, NKVM = 2048;
constexpr int DFF = 5632, DFFE = 7168, NEXP = 8;
constexpr int NOATT = 3072;
constexpr float ALPHA = 1.4142135623730951f;
constexpr float LN_EPS = 1e-5f, RMS_EPS = 1e-6f;
constexpr float LOG2E = 1.4426950408889634f;
constexpr float C2_128 = 0.12751743082459868f;
constexpr float C2_192 = 0.10411754627697264f;
constexpr float W13_SCALE = 256.f, W2_SCALE = 1024.f, X_SCALE = 8.f, H_SCALE = 4.f;
constexpr int MOE_MAXT = 136;

constexpr size_t MiB = 1u << 20;
constexpr size_t WS_CTL = 0, CTL_ZERO_BYTES = 1 * MiB;
constexpr size_t WS_COS = 1 * MiB, WS_SIN = 3 * MiB;
constexpr size_t WS_SSQ = 5 * MiB;
constexpr size_t WS_LF = 6 * MiB;
constexpr size_t WS_CB = 6 * MiB + 512 * 1024;
constexpr size_t WS_KMH = 7 * MiB, WS_KML = 7 * MiB + 128 * 1024;
constexpr size_t WS_TKN = 7 * MiB + 512 * 1024;
constexpr size_t WS_LTOK = 8 * MiB, WS_LDST = 8 * MiB + 512 * 1024, WS_LGATE = 9 * MiB;
constexpr size_t WS_KPE = 10 * MiB;
constexpr size_t WS_WQB = 16 * MiB;
constexpr size_t WS_WKVB = 19 * MiB;
constexpr size_t WS_WBR = 23 * MiB;
constexpr size_t WS_WO = 47 * MiB;
constexpr size_t WS_WIN = 63 * MiB;
constexpr size_t WS_WF13 = 169 * MiB;
constexpr size_t WS_WF2 = 213 * MiB;
constexpr size_t WS_WM13 = 235 * MiB;
constexpr size_t WS_WM2 = 459 * MiB;
constexpr size_t WS_XBF = 672 * MiB;
constexpr size_t WS_WINF = 704 * MiB;
constexpr int NWIN16 = 29 * 256;
constexpr size_t WS_XB = 907 * MiB;
constexpr size_t WS_X1 = 972 * MiB;
constexpr size_t WS_PROJ = 1037 * MiB;
constexpr size_t WS_QM = 1461 * MiB;
constexpr size_t WS_KVM = 1509 * MiB;
constexpr size_t WS_HID = WS_PROJ;
constexpr size_t WS_XGFR = 1280 * MiB;
static_assert(WS_PROJ + (size_t)(136 * 256) * 7168 <= WS_XGFR && WS_XGFR + (size_t)8 * 16384 * 2048 <= 1573 * MiB, "ws map: XGFR between the MoE hidden and OATT");
constexpr size_t WS_OATT = 1573 * MiB;
constexpr size_t WS_MERGED = 1669 * MiB;
constexpr size_t WS_YMOE = WS_OATT;
constexpr size_t WS_Y = 1733 * MiB;
constexpr size_t WS_END = 1870 * MiB;
static_assert(WS_PROJ + (size_t)MTOK * NPROJ * 2 <= WS_QM && WS_HID + (size_t)(MOE_MAXT * 256) * DFFE * 2 <= WS_OATT, "ws map");
constexpr int CW_CNT = 64;
constexpr int CW_BAR = 4096;

constexpr int RING_BYTES = 131072;
constexpr int MISC_OFF = RING_BYTES + 320;
constexpr int LDS_BYTES = 147456;
constexpr int NWAVES = 8;

#define RLX_AGENT __ATOMIC_RELAXED, __HIP_MEMORY_SCOPE_AGENT
#define LDS_WAIT() asm volatile("s_waitcnt lgkmcnt(0)" ::: "memory")
#define VM_WAIT() asm volatile("s_waitcnt vmcnt(0)" ::: "memory")
#define SBAR() __builtin_amdgcn_sched_barrier(0)
__device__ __forceinline__ unsigned cvt_pk_bf16(float lo, float hi) { unsigned r; asm volatile("v_cvt_pk_bf16_f32 %0, %1, %2" : "=v"(r) : "v"(lo), "v"(hi)); return r; }
__device__ __forceinline__ u32x4 pack8(f32x4 a, f32x4 b) { u32x4 w; w.x = cvt_pk_bf16(a[0], a[1]); w.y = cvt_pk_bf16(a[2], a[3]); w.z = cvt_pk_bf16(b[0], b[1]); w.w = cvt_pk_bf16(b[2], b[3]); return w; }
__device__ __forceinline__ unsigned pk4_fp8(float a, float b, float c, float d) { int w = 0; w = __builtin_amdgcn_cvt_pk_fp8_f32(a, b, w, false); w = __builtin_amdgcn_cvt_pk_fp8_f32(c, d, w, true); return (unsigned)w; }
__device__ __forceinline__ float bf_lo(unsigned w) { return __uint_as_float(w << 16); }
__device__ __forceinline__ float bf_hi(unsigned w) { return __uint_as_float(w & 0xffff0000u); }
__device__ __forceinline__ void unpack8(u32x4 w, f32x4& a, f32x4& b) { a[0] = bf_lo(w.x); a[1] = bf_hi(w.x); a[2] = bf_lo(w.y); a[3] = bf_hi(w.y); b[0] = bf_lo(w.z); b[1] = bf_hi(w.z); b[2] = bf_lo(w.w); b[3] = bf_hi(w.w); }
__device__ __forceinline__ float fast_sigmoid(float x) { return __builtin_amdgcn_rcpf(1.0f + __builtin_amdgcn_exp2f(-x * LOG2E)); }
template <int X> __device__ __forceinline__ float swz_xor(float v) { return __int_as_float(__builtin_amdgcn_ds_swizzle(__float_as_int(v), (X << 10) | 0x1f)); }
__device__ __forceinline__ float sum_xor32(float v) { auto rr = __builtin_amdgcn_permlane32_swap(__float_as_uint(v), __float_as_uint(v), false, false); return __uint_as_float(rr[0]) + __uint_as_float(rr[1]); }
__device__ __forceinline__ float wave_sum(float v) { v += swz_xor<1>(v); v += swz_xor<2>(v); v += swz_xor<4>(v); v += swz_xor<8>(v); v += swz_xor<16>(v); return sum_xor32(v); }

__device__ __forceinline__ unsigned char* assume_global(unsigned char* p) {
#if defined(__HIP_DEVICE_COMPILE__)
    __builtin_assume(!__builtin_amdgcn_is_shared((const __attribute__((address_space(0))) void*)p) && !__builtin_amdgcn_is_private((const __attribute__((address_space(0))) void*)p));
#endif
    return p;
}
__device__ __forceinline__ int my_tid(int wave0) { int lane; asm volatile("v_mbcnt_lo_u32_b32 %0, -1, 0\n\tv_mbcnt_hi_u32_b32 %0, -1, %0" : "=v"(lane)); return wave0 * 64 + lane; }

namespace pg8 {
constexpr int BM = 256, BK = 64, HALF = 128, HTB = HALF * BK * 2, STAGE_BYTES = 8 * HTB, NXCD = 8, WGM = 8;
__host__ __device__ __forceinline__ int lds_byte(int r, int c) { const int st = (r >> 4) * 2 + (c >> 5), rr = r & 15, cc = c & 31, ob = rr * 64 + cc * 2; return st * 1024 + (ob ^ (((ob >> 9) & 1) << 5)); }
__host__ __device__ __forceinline__ void stage_rc(int b, int& R, int& C) { const int st = b / 1024, sb = b % 1024, swz = sb ^ (((sb >> 9) & 1) << 5); R = (st >> 1) * 16 + swz / 64; C = (st & 1) * 32 + (swz % 64) / 2; }
__host__ __device__ __forceinline__ int perm32(int rho) { const int n = rho >> 4, i = rho & 15; return 8 * (i >> 2) + 4 * n + (i & 3); }

struct Unit { int pm, pn, tag; unsigned A, B; };
struct Shape { int K, lda, ldb; };

__device__ __forceinline__ void tile_map(int L, int nM, int nN, int& pm, int& pn) {
    const int nwg = nM * nN; int wgid = L;
    { const int q = nwg / NXCD, r = nwg % NXCD, xcd = wgid % NXCD, off = wgid / NXCD; wgid = (xcd < r ? xcd * (q + 1) : r * (q + 1) + (xcd - r) * q) + off; }
    const int nig = WGM * nN, gid = wgid / nig, fm = gid * WGM, gsz = (nM - fm) < WGM ? (nM - fm) : WGM;
    pm = __builtin_amdgcn_readfirstlane(fm + ((wgid % nig) % gsz)); pn = __builtin_amdgcn_readfirstlane((wgid % nig) / gsz);
}

__device__ __forceinline__ const char* uni_ptr(const char* p) { const unsigned long long v = (unsigned long long)p; const unsigned lo = __builtin_amdgcn_readfirstlane((unsigned)v), hi = __builtin_amdgcn_readfirstlane((unsigned)(v >> 32)); return (const char*)(((unsigned long long)hi << 32) | lo); }
__device__ __forceinline__ void glds16_s(const char* sbase, unsigned voff, unsigned lds_dst) { unsigned keep;
    asm volatile("s_mov_b32 %0, m0\n\ts_mov_b32 m0, %3\n\ts_nop 0\n\tglobal_load_lds_dwordx4 %1, %2\n\ts_mov_b32 m0, %0" : "=&s"(keep) : "v"(voff), "s"(sbase), "s"(lds_dst) : "memory"); }
typedef int i32x8 __attribute__((ext_vector_type(8)));
typedef int i32x4 __attribute__((ext_vector_type(4)));
__device__ __forceinline__ i32x8 cat8(bf16x8 a, bf16x8 b) { return __builtin_shufflevector(__builtin_bit_cast(i32x4, a), __builtin_bit_cast(i32x4, b), 0, 1, 2, 3, 4, 5, 6, 7); }
template <class Epi, class Sched, bool FP8 = false>
__device__ __forceinline__ void gemm_phase(LAS unsigned char* lds, const char* wsb, int wave0, const Shape g, const Sched& S, const Epi& E) {
    const int tid = my_tid(wave0);
    const int wid = __builtin_amdgcn_readfirstlane(tid >> 6), lane = tid & 63, wr = wid >> 2, wc = wid & 3, fr = lane & 15, fq = lane >> 4;
    const int K = g.K, nt = K / BK;
    unsigned voffA[2], voffB[2];
#pragma unroll
    for (int i = 0; i < 2; ++i) { int R, C; stage_rc(tid * 16 + i * 8192, R, C); const int Rb = Epi::PERM ? ((R & ~31) + perm32(R & 31)) : R;
        voffA[i] = (unsigned)(R * g.lda + C) * 2u; voffB[i] = (unsigned)(Rb * g.ldb + C) * 2u; }
    const unsigned kstep = (unsigned)(BK * 2);
    const unsigned hstepA = (unsigned)HALF * g.lda * 2, hstepB = (unsigned)HALF * g.ldb * 2;
    const unsigned ldsw = (unsigned)wid * 1024u; const unsigned ldsbase = (unsigned)(size_t)lds;
    const int aoff = lds_byte(wr * 64 + fr, fq * 8), boff = lds_byte(wc * 32 + fr, fq * 8);
#define PG8_SA(b, h) (((b) * 2 + (h)) * HTB)
#define PG8_SB(b, h) ((4 + (b) * 2 + (h)) * HTB)
#define PG8_STAGE(bufoff, goff, voff) do { _Pragma("unroll") for (int _i = 0; _i < 2; ++_i) glds16_s(wsb, (voff)[_i] + (unsigned)(goff), ldsbase + (unsigned)((bufoff) + _i * 8192) + ldsw); } while (0)
#define PG8_LDA(dst, b, h) do { _Pragma("unroll") for (int m = 0; m < 4; ++m) { \
        if constexpr (FP8) { const i32x4 lo_ = *(const LAS i32x4*)(lds + PG8_SA(b, h) + aoff + m * 2048), hi_ = *(const LAS i32x4*)(lds + PG8_SA(b, h) + aoff + m * 2048 + 1024); dst##8[m] = __builtin_shufflevector(lo_, hi_, 0, 1, 2, 3, 4, 5, 6, 7); } \
        else { _Pragma("unroll") for (int k = 0; k < 2; ++k) dst[m][k] = *(const LAS bf16x8*)(lds + PG8_SA(b, h) + aoff + m * 2048 + k * 1024); } } } while (0)
#define PG8_LDB(dst, b, h) do { _Pragma("unroll") for (int n = 0; n < 2; ++n) { \
        if constexpr (FP8) { const i32x4 lo_ = *(const LAS i32x4*)(lds + PG8_SB(b, h) + boff + n * 2048), hi_ = *(const LAS i32x4*)(lds + PG8_SB(b, h) + boff + n * 2048 + 1024); dst##8[n] = __builtin_shufflevector(lo_, hi_, 0, 1, 2, 3, 4, 5, 6, 7); } \
        else { _Pragma("unroll") for (int k = 0; k < 2; ++k) dst[n][k] = *(const LAS bf16x8*)(lds + PG8_SB(b, h) + boff + n * 2048 + k * 1024); } } } while (0)
#define PG8_MMA(ai, bj, At, Bt) do { __builtin_amdgcn_s_setprio(1); \
        if constexpr (FP8) { _Pragma("unroll") for (int m = 0; m < 4; ++m) _Pragma("unroll") for (int n = 0; n < 2; ++n) \
            acc[ai][bj][m][n] = __builtin_amdgcn_mfma_scale_f32_16x16x128_f8f6f4(Bt##8[n], At##8[m], acc[ai][bj][m][n], 0, 0, 0, 0, 0, 0); } \
        else { _Pragma("unroll") for (int m = 0; m < 4; ++m) _Pragma("unroll") for (int n = 0; n < 2; ++n) _Pragma("unroll") for (int k = 0; k < 2; ++k) \
            acc[ai][bj][m][n] = __builtin_amdgcn_mfma_f32_16x16x32_bf16(Bt[n][k], At[m][k], acc[ai][bj][m][n], 0, 0, 0); } \
        __builtin_amdgcn_s_setprio(0); } while (0)
#define PG8_WAIT_V(n) asm volatile("s_waitcnt vmcnt(" #n ")" ::: "memory")
#define PG8_WAIT_L(n) asm volatile("s_waitcnt lgkmcnt(" #n ")" ::: "memory")
#define PG8_BAR __builtin_amdgcn_s_barrier()
#define PG8_SCHED __builtin_amdgcn_sched_barrier(0)
    Unit cur, nxt; int ui = 0;
    if (!S.next(0, cur)) return;
    f32x4 acc[2][2][4][2];
#define PG8_ZERO_ACC() do { _Pragma("unroll") for (int a = 0; a < 2; ++a) _Pragma("unroll") for (int b = 0; b < 2; ++b) _Pragma("unroll") for (int m = 0; m < 4; ++m) _Pragma("unroll") for (int n = 0; n < 2; ++n) \
        _Pragma("unroll") for (int j = 0; j < 4; ++j) { float z_; asm volatile("v_mov_b32 %0, 0" : "=v"(z_)); acc[a][b][m][n][j] = z_; } } while (0)
    PG8_ZERO_ACC();
    bf16x8 At[4][2], B0[2][2], B1[2][2]; i32x8 At8[4], B08[2], B18[2]; (void)At; (void)B0; (void)B1; (void)At8; (void)B08; (void)B18;
    unsigned cA = __builtin_amdgcn_readfirstlane(cur.A), cB = __builtin_amdgcn_readfirstlane(cur.B);
    PG8_STAGE(PG8_SB(0, 0), cB, voffB); PG8_STAGE(PG8_SB(0, 1), cB + hstepB, voffB); PG8_STAGE(PG8_SA(0, 0), cA, voffA); PG8_STAGE(PG8_SA(0, 1), cA + hstepA, voffA);
    if (wr == 1) PG8_BAR;
    PG8_WAIT_V(2); PG8_BAR;
    PG8_STAGE(PG8_SB(1, 0), cB + kstep, voffB); PG8_STAGE(PG8_SA(1, 0), cA + kstep, voffA); PG8_STAGE(PG8_SB(1, 1), cB + hstepB + kstep, voffB);
    PG8_WAIT_V(6); PG8_BAR;
    for (;;) {
        const bool has_next = S.next(ui + 1, nxt);
        const unsigned nA = has_next ? __builtin_amdgcn_readfirstlane(nxt.A) : cA, nB = has_next ? __builtin_amdgcn_readfirstlane(nxt.B) : cB;
        for (int t = 0; t < nt; t += 2) {
            const bool last = (t == nt - 2);
            const unsigned a1 = cA + (unsigned)(t + 1) * kstep;
            const unsigned a2 = last ? nA : cA + (unsigned)(t + 2) * kstep, b2 = last ? nB : cB + (unsigned)(t + 2) * kstep;
            const unsigned a3 = a2 + kstep, b3 = b2 + kstep;
            PG8_LDB(B0, 0, 0); PG8_LDB(B1, 0, 1); PG8_SCHED; PG8_LDA(At, 0, 0); PG8_STAGE(PG8_SA(1, 1), a1 + hstepA, voffA);
            PG8_WAIT_V(8); PG8_WAIT_L(0); PG8_BAR; PG8_MMA(0, 0, At, B0); PG8_MMA(0, 1, At, B1); PG8_BAR; PG8_SCHED;
            PG8_LDA(At, 0, 1); PG8_STAGE(PG8_SB(0, 0), b2, voffB); PG8_STAGE(PG8_SB(0, 1), b2 + hstepB, voffB); PG8_STAGE(PG8_SA(0, 0), a2, voffA);
            PG8_WAIT_V(8); PG8_WAIT_L(0); PG8_BAR; PG8_MMA(1, 0, At, B0); PG8_MMA(1, 1, At, B1); PG8_BAR; PG8_SCHED;
            PG8_LDB(B0, 1, 0); PG8_LDB(B1, 1, 1); PG8_SCHED; PG8_LDA(At, 1, 0); PG8_STAGE(PG8_SA(0, 1), a2 + hstepA, voffA);
            PG8_WAIT_V(8); PG8_WAIT_L(0); PG8_BAR; PG8_MMA(0, 0, At, B0); PG8_MMA(0, 1, At, B1); PG8_BAR; PG8_SCHED;
            PG8_LDA(At, 1, 1); PG8_STAGE(PG8_SB(1, 0), b3, voffB); PG8_STAGE(PG8_SB(1, 1), b3 + hstepB, voffB); PG8_STAGE(PG8_SA(1, 0), a3, voffA);
            PG8_WAIT_V(8); PG8_WAIT_L(0); PG8_BAR; PG8_MMA(1, 0, At, B0); PG8_MMA(1, 1, At, B1); PG8_BAR; PG8_SCHED;
        }
        if (wr == 0) PG8_BAR;
        { const int l2 = my_tid(wave0) & 63;
          E(acc, cur, wr, wc, l2 & 15, l2 >> 4); }
        if (!has_next) break;
        PG8_ZERO_ACC();
        cur = nxt; cA = nA; cB = nB; ++ui;
        if (wr == 1) PG8_BAR;
    }
    PG8_WAIT_V(0);
    PG8_BAR;
#undef PG8_ZERO_ACC
#undef PG8_SA
#undef PG8_SB
#undef PG8_STAGE
#undef PG8_LDA
#undef PG8_LDB
#undef PG8_MMA
#undef PG8_WAIT_V
#undef PG8_WAIT_L
#undef PG8_BAR
#undef PG8_SCHED
}
}

struct SchedPlain {
    int nM, nN, G, c; unsigned A, B, tA, tB;
    __device__ __forceinline__ bool next(int i, pg8::Unit& u) const {
        const long L = (long)i * G + c; if (L >= (long)nM * nN) return false;
        pg8::tile_map((int)L, nM, nN, u.pm, u.pn); u.tag = 0; u.A = A + (unsigned)u.pm * tA; u.B = B + (unsigned)u.pn * tB; return true;
    }
};
struct SchedGates {
    int G, c; unsigned A, B;
    __device__ __forceinline__ bool next(int i, pg8::Unit& u) const {
        long L;
        if (G == 256) { if (i < 5) L = (long)i * 256 + c; else if (i == 5) { if (c < 64) return false; L = 1280 + (c - 64); } else if (i == 6) { if (c < 64 || c >= 128) return false; L = 1472 + (c - 64); } else return false; }
        else { L = (long)i * G + c; if (L >= 64 * 24) return false; }
        pg8::tile_map((int)L, 64, 24, u.pm, u.pn); u.tag = 0; u.A = A + (unsigned)u.pm * (256u * DM); u.B = B + (unsigned)u.pn * (256u * DM); return true;
    }
};
struct SchedMlaUp {
    int G, c; unsigned Aq, Akv, Bq, Bkv;
    __device__ __forceinline__ bool next(int i, pg8::Unit& u) const {
        const long L = (long)i * G + c; if (L >= 64 * 14) return false;
        int pm, pv; pg8::tile_map((int)L, 64, 14, pm, pv); u.pm = pm;
        const unsigned tA = 256u * NPROJ * 2, tB = 256u * QLORA * 2;
        if (pv < 6) { u.pn = pv; u.tag = 0; u.A = Aq + (unsigned)pm * tA; u.B = Bq + (unsigned)pv * tB; }
        else { u.pn = pv - 6; u.tag = 1; u.A = Akv + (unsigned)pm * tA; u.B = Bkv + (unsigned)(pv - 6) * tB; }
        return true;
    }
};
struct SchedMerge {
    int G, c; unsigned A, B;
    __device__ __forceinline__ bool next(int i, pg8::Unit& u) const {
        const int r = i / 3, br = i - 3 * r; const long L = (long)r * G + c; if (L >= 512) return false;
        pg8::tile_map((int)L, 64, 8, u.pm, u.pn); u.tag = br;
        u.A = A + (unsigned)u.pm * (256u * NOATT * 2) + (unsigned)br * 2048u; u.B = B + (unsigned)br * ((unsigned)DM * 1024 * 2) + (unsigned)u.pn * (256u * 1024 * 2); return true;
    }
};
struct SchedMoe {
    int nM, nN, G, c; unsigned A, B, tA, tB, eB; unsigned long long tbp; int regA;
    __device__ __forceinline__ bool next(int i, pg8::Unit& u) const {
        const long L = (long)i * G + c; if (L >= (long)nM * nN) return false;
        pg8::tile_map((int)L, nM, nN, u.pm, u.pn); int e = 0;
#pragma unroll
        for (int j = 0; j < 7; ++j) e += (u.pm >= (int)((tbp >> (8 * j)) & 255ull)) ? 1 : 0;
        e = __builtin_amdgcn_readfirstlane(e);
        const int tbe = (e == 0) ? 0 : (int)((tbp >> (8 * (e - 1))) & 255ull);
        u.tag = e; u.A = regA ? A + ((unsigned)e * (unsigned)(MTOK / 256) + (unsigned)(u.pm - tbe)) * tA : A + (unsigned)u.pm * tA; u.B = B + (unsigned)e * eB + (unsigned)u.pn * tB; return true;
    }
};

struct EpiInProj {
    static constexpr bool PERM = true;
    bf16_t* proj; float* ssq; const float* cosT; const float* sinT; bf16_t* kpe; float* lf; const float* bforget;
    __device__ __forceinline__ void operator()(const f32x4 (&acc)[2][2][4][2], const pg8::Unit& u, int wr, int wc, int fr, int fq) const {
        const int row0 = u.pm * 256 + wr * 64 + fr, col0 = wc * 32 + 8 * fq;
        if (u.pn < 28) {
            const float sc = __int_as_float(__builtin_amdgcn_readfirstlane((u.pn < 4 || (u.pn >= 12 && u.pn < 16)) ? __float_as_int(C2_128) : __float_as_int(1.0f)));
            const bool dossq = (u.pn >= 24 && u.pn < 28);
#pragma unroll
            for (int ai = 0; ai < 2; ++ai)
#pragma unroll
                for (int m = 0; m < 4; ++m) { const int row = row0 + ai * 128 + m * 16; bf16_t* rowp = proj + (size_t)row * NPROJ + u.pn * 256 + col0; float s = 0.f;
#pragma unroll
                    for (int bj = 0; bj < 2; ++bj) { const f32x4 v0 = acc[ai][bj][m][0] * sc, v1 = acc[ai][bj][m][1] * sc;
                        s += (v0[0] * v0[0] + v0[1] * v0[1]) + (v0[2] * v0[2] + v0[3] * v0[3]) + (v1[0] * v1[0] + v1[1] * v1[1]) + (v1[2] * v1[2] + v1[3] * v1[3]);
                        *(u32x4*)(rowp + bj * 128) = pack8(v0, v1); }
                    if (dossq) { s += swz_xor<16>(s); s = sum_xor32(s); if (fq == 0) ssq[(size_t)row * 16 + (u.pn - 24) * 4 + wc] = s; } }
        } else {
            if (wc < 2) {
#pragma unroll
                for (int ai = 0; ai < 2; ++ai)
#pragma unroll
                    for (int m = 0; m < 4; ++m) { const int row = row0 + ai * 128 + m * 16; const int i0 = 16 * wc + 4 * fq;
                        const f32x4 cs = *(const f32x4*)(cosT + (size_t)row * 32 + i0), sn = *(const f32x4*)(sinT + (size_t)row * 32 + i0);
                        const f32x4 v0 = acc[ai][0][m][0], v1 = acc[ai][0][m][1]; f32x4 o0, o1;
                        o0[0] = v0[0] * cs[0] - v0[1] * sn[0]; o0[1] = v0[1] * cs[0] + v0[0] * sn[0]; o0[2] = v0[2] * cs[1] - v0[3] * sn[1]; o0[3] = v0[3] * cs[1] + v0[2] * sn[1];
                        o1[0] = v1[0] * cs[2] - v1[1] * sn[2]; o1[1] = v1[1] * cs[2] + v1[0] * sn[2]; o1[2] = v1[2] * cs[3] - v1[3] * sn[3]; o1[3] = v1[3] * cs[3] + v1[2] * sn[3];
                        *(u32x4*)(kpe + (size_t)row * 64 + col0) = pack8(o0, o1); }
            } else if (wc == 2 && fq == 0) {
                const f32x4 b0 = *(const f32x4*)(bforget), b1 = *(const f32x4*)(bforget + 4);
#pragma unroll
                for (int ai = 0; ai < 2; ++ai)
#pragma unroll
                    for (int m = 0; m < 4; ++m) { const int row = row0 + ai * 128 + m * 16; f32x4 z0 = acc[ai][0][m][0] + b0, z1 = acc[ai][0][m][1] + b1;
#pragma unroll
                        for (int j = 0; j < 4; ++j) { z0[j] = fminf(z0[j], 0.f) - log1pf(expf(-fabsf(z0[j]))); z1[j] = fminf(z1[j], 0.f) - log1pf(expf(-fabsf(z1[j]))); }
                        *(f32x4*)(lf + (size_t)row * 8) = z0; *(f32x4*)(lf + (size_t)row * 8 + 4) = z1; }
            }
        }
    }
};
struct EpiGates8 {
    static constexpr bool PERM = true;
    bf16_t* proj;
    __device__ __forceinline__ void operator()(const f32x4 (&acc)[2][2][4][2], const pg8::Unit& u, int wr, int wc, int fr, int fq) const {
        const int row0 = u.pm * 256 + wr * 64 + fr, col0 = C_GATE + u.pn * 256 + wc * 32 + 8 * fq; const float ds = 1.0f / (X_SCALE * W13_SCALE);
#pragma unroll
        for (int ai = 0; ai < 2; ++ai)
#pragma unroll
            for (int m = 0; m < 4; ++m) { bf16_t* rowp = proj + (size_t)(row0 + ai * 128 + m * 16) * NPROJ + col0;
#pragma unroll
                for (int bj = 0; bj < 2; ++bj) *(u32x4*)(rowp + bj * 128) = pack8(acc[ai][bj][m][0] * ds, acc[ai][bj][m][1] * ds); }
    }
};
struct EpiMlaUp {
    static constexpr bool PERM = true;
    bf16_t* qm; bf16_t* kvm; const float* ssq; const float* cosT; const float* sinT;
    __device__ __forceinline__ void operator()(const f32x4 (&acc)[2][2][4][2], const pg8::Unit& u, int wr, int wc, int fr, int fq) const {
        const int row0 = u.pm * 256 + wr * 64 + fr, col0 = wc * 32 + 8 * fq;
#pragma unroll
        for (int ai = 0; ai < 2; ++ai)
#pragma unroll
            for (int m = 0; m < 4; ++m) { const int row = row0 + ai * 128 + m * 16;
                const f32x4 s0 = *(const f32x4*)(ssq + (size_t)row * 16 + u.tag * 8), s1 = *(const f32x4*)(ssq + (size_t)row * 16 + u.tag * 8 + 4);
                const float ss = ((s0[0] + s0[1]) + (s0[2] + s0[3])) + ((s1[0] + s1[1]) + (s1[2] + s1[3]));
                float rs = 1.0f / sqrtf(ss * (1.0f / 512.0f) + RMS_EPS);
                if (u.tag == 0) {
                    rs *= C2_192; bf16_t* rowp = qm + (size_t)row * NQM + u.pn * 256 + col0;
                    if (u.pn < 4) {
#pragma unroll
                        for (int bj = 0; bj < 2; ++bj) *(u32x4*)(rowp + bj * 128) = pack8(acc[ai][bj][m][0] * rs, acc[ai][bj][m][1] * rs);
                    } else {
#pragma unroll
                        for (int bj = 0; bj < 2; ++bj) { const int jj = (bj * 128 + col0) & 63, i0 = jj >> 1;
                            const f32x4 cs = *(const f32x4*)(cosT + (size_t)row * 32 + i0), sn = *(const f32x4*)(sinT + (size_t)row * 32 + i0);
                            const f32x4 v0 = acc[ai][bj][m][0] * rs, v1 = acc[ai][bj][m][1] * rs; f32x4 o0, o1;
                            o0[0] = v0[0] * cs[0] - v0[1] * sn[0]; o0[1] = v0[1] * cs[0] + v0[0] * sn[0]; o0[2] = v0[2] * cs[1] - v0[3] * sn[1]; o0[3] = v0[3] * cs[1] + v0[2] * sn[1];
                            o1[0] = v1[0] * cs[2] - v1[1] * sn[2]; o1[1] = v1[1] * cs[2] + v1[0] * sn[2]; o1[2] = v1[2] * cs[3] - v1[3] * sn[3]; o1[3] = v1[3] * cs[3] + v1[2] * sn[3];
                            *(u32x4*)(rowp + bj * 128) = pack8(o0, o1); }
                    }
                } else {
                    bf16_t* rowp = kvm + (size_t)row * NKVM + u.pn * 256 + col0;
#pragma unroll
                    for (int bj = 0; bj < 2; ++bj) *(u32x4*)(rowp + bj * 128) = pack8(acc[ai][bj][m][0] * rs, acc[ai][bj][m][1] * rs);
                }
            }
    }
};
struct EpiGateMerge {
    static constexpr bool PERM = true;
    const bf16_t* proj; bf16_t* merged;
    __device__ __forceinline__ void operator()(const f32x4 (&acc)[2][2][4][2], const pg8::Unit& u, int wr, int wc, int fr, int fq) const {
        const int row0 = u.pm * 256 + wr * 64 + fr, col0 = u.pn * 256 + wc * 32 + 8 * fq;
#pragma unroll
        for (int ai = 0; ai < 2; ++ai)
#pragma unroll
            for (int m = 0; m < 4; ++m) { const int row = row0 + ai * 128 + m * 16;
#pragma unroll
                for (int bj = 0; bj < 2; ++bj) { const int col = col0 + bj * 128;
                    const u32x4 gw = *(const u32x4*)(proj + (size_t)row * NPROJ + C_GATE + u.tag * 2048 + col); f32x4 g0, g1; unpack8(gw, g0, g1);
                    f32x4 v0 = acc[ai][bj][m][0], v1 = acc[ai][bj][m][1];
#pragma unroll
                    for (int j = 0; j < 4; ++j) { v0[j] *= fast_sigmoid(g0[j]); v1[j] *= fast_sigmoid(g1[j]); }
                    bf16_t* op = merged + (size_t)row * DM + col;
                    if (u.tag > 0) { const u32x4 pw = *(const u32x4*)op; f32x4 p0, p1; unpack8(pw, p0, p1); v0 += p0; v1 += p1; }
                    *(u32x4*)op = pack8(v0, v1); } }
    }
};
struct EpiResidual {
    static constexpr bool PERM = true;
    const bf16_t* res; bf16_t* y;
    __device__ __forceinline__ void operator()(const f32x4 (&acc)[2][2][4][2], const pg8::Unit& u, int wr, int wc, int fr, int fq) const {
        const int row0 = u.pm * 256 + wr * 64 + fr, col0 = u.pn * 256 + wc * 32 + 8 * fq;
#pragma unroll
        for (int ai = 0; ai < 2; ++ai)
#pragma unroll
            for (int m = 0; m < 4; ++m) { const size_t off = (size_t)(row0 + ai * 128 + m * 16) * DM + col0;
#pragma unroll
                for (int bj = 0; bj < 2; ++bj) { const u32x4 rw = *(const u32x4*)(res + off + bj * 128); f32x4 r0, r1; unpack8(rw, r0, r1);
                    *(u32x4*)(y + off + bj * 128) = pack8(r0 * ALPHA + acc[ai][bj][m][0], r1 * ALPHA + acc[ai][bj][m][1]); } }
    }
};
struct EpiSwiGLU {
    static constexpr bool PERM = true;
    bf16_t* hid; int ldh;
    __device__ __forceinline__ void operator()(const f32x4 (&acc)[2][2][4][2], const pg8::Unit& u, int wr, int wc, int fr, int fq) const {
        const int row0 = u.pm * 256 + wr * 64 + fr, col0 = u.pn * 128 + wc * 32 + 8 * fq;
#pragma unroll
        for (int ai = 0; ai < 2; ++ai)
#pragma unroll
            for (int m = 0; m < 4; ++m) { f32x4 h0, h1;
#pragma unroll
                for (int j = 0; j < 4; ++j) { const float a0 = acc[ai][0][m][0][j], a1 = acc[ai][0][m][1][j];
                    h0[j] = a0 * fast_sigmoid(a0) * acc[ai][1][m][0][j]; h1[j] = a1 * fast_sigmoid(a1) * acc[ai][1][m][1][j]; }
                *(u32x4*)(hid + (size_t)(row0 + ai * 128 + m * 16) * ldh + col0) = pack8(h0, h1); }
    }
};
struct EpiSwiGLU8 {
    static constexpr bool PERM = true;
    unsigned char* hid; int ldh;
    __device__ __forceinline__ void operator()(const f32x4 (&acc)[2][2][4][2], const pg8::Unit& u, int wr, int wc, int fr, int fq) const {
        const int row0 = u.pm * 256 + wr * 64 + fr, col0 = u.pn * 128 + wc * 32 + 8 * fq; const float ds = 1.0f / (X_SCALE * W13_SCALE);
#pragma unroll
        for (int ai = 0; ai < 2; ++ai)
#pragma unroll
            for (int m = 0; m < 4; ++m) { f32x4 h0, h1;
#pragma unroll
                for (int j = 0; j < 4; ++j) { const float a0 = acc[ai][0][m][0][j] * ds, a1 = acc[ai][0][m][1][j] * ds;
                    h0[j] = a0 * fast_sigmoid(a0) * (acc[ai][1][m][0][j] * (ds * H_SCALE)); h1[j] = a1 * fast_sigmoid(a1) * (acc[ai][1][m][1][j] * (ds * H_SCALE)); }
                u32x2 w; w.x = pk4_fp8(h0[0], h0[1], h0[2], h0[3]); w.y = pk4_fp8(h1[0], h1[1], h1[2], h1[3]);
                *(u32x2*)(hid + (size_t)(row0 + ai * 128 + m * 16) * ldh + col0) = w; }
    }
};
struct EpiMoeDown {
    static constexpr bool PERM = true;
    bf16_t* ymoe; const int* ldst; const float* lgate; unsigned long long tbp; const unsigned* cntp;
    __device__ __forceinline__ void operator()(const f32x4 (&acc)[2][2][4][2], const pg8::Unit& u, int wr, int wc, int fr, int fq) const {
        const int e = u.tag; const int tbe = (int)((tbp >> (8 * e)) & 255ull);
        int ce = (int)__hip_atomic_load(cntp + e, RLX_AGENT); if (ce > MTOK) ce = MTOK;
        const int pos0 = (u.pm - tbe) * 256 + wr * 64 + fr, col0 = u.pn * 256 + wc * 32 + 8 * fq;
#pragma unroll
        for (int ai = 0; ai < 2; ++ai)
#pragma unroll
            for (int m = 0; m < 4; ++m) { const int pos = pos0 + ai * 128 + m * 16;
                if (pos < ce) { const int dst = ldst[e * MTOK + pos]; const float gt = lgate[e * MTOK + pos] * (1.0f / (H_SCALE * W2_SCALE)); bf16_t* rowp = ymoe + (size_t)dst * DM + col0;
#pragma unroll
                    for (int bj = 0; bj < 2; ++bj) *(u32x4*)(rowp + bj * 128) = pack8(acc[ai][bj][m][0] * gt, acc[ai][bj][m][1] * gt); } }
    }
};

namespace att {
constexpr int KVBLK = 64, QBLK = 32, QB = 256;
constexpr int SHM_V = 16384, SHM_K = 16384, SHM_KPE = 8192;
constexpr int L_V = 0, L_K = 2 * SHM_V, L_KPE = L_K + 2 * SHM_K, L_BIAS = L_KPE + 2 * SHM_KPE, L_TAB = L_BIAS + 512, L_WS = L_TAB + 256, L_NEED = L_WS + 8 * 256, L_PKN = L_NEED + 256, L_DEAD = L_PKN + 256, L_END = L_DEAD + 64, L_OST = 0;
static_assert(L_END <= RING_BYTES, "attention LDS");
constexpr float THRL = 8.0f;
constexpr int NW_ATT = 8;
#define KSWZ(row, colB) ((row) * 256 + ((colB) ^ (((row) & 7) << 4)))
__device__ __forceinline__ int v_st(int k, int c) { const int kk = (k & ~0xC) | ((k & 4) << 1) | ((k & 8) >> 1); return ((kk >> 3) * 4 + (c >> 5)) * 512 + ((kk & 7) * 32 + (c & 31)) * 2; }
__device__ __forceinline__ int v_rd_base(int lane) { return ((lane & 3) << 3) | (((lane >> 2) & 3) << 6) | (((lane >> 4) & 1) << 5) | (((lane >> 5) & 1) << 8); }
__device__ __forceinline__ int crow(int r, int hi) { return (r & 3) + 8 * (r >> 2) + 4 * hi; }
enum { MOBA = 0, FOX = 1, MLA = 2 };
struct Args { const bf16_t* q; int ldq; const bf16_t* qr; const bf16_t* k; int ldk; const bf16_t* kr; const bf16_t* v; int ldv; bf16_t* o; const float* cb; const bf16_t* kmh; const bf16_t* kml; const float* tkn; };

template <int MODE>
__device__ __forceinline__ void attn_unit(const Args& a, int b, int h, int qb, LAS unsigned char* lds, int wave0) {
    const int tid = my_tid(wave0);
    const int wid = __builtin_amdgcn_readfirstlane(tid >> 6), lane = tid & 63, r32 = lane & 31, hi = lane >> 5;
    const size_t rowbase = (size_t)b * SEQ; const int q0 = qb * QB;
    LAS unsigned char* V_lds = lds + L_V; LAS unsigned char* K_lds = lds + L_K; LAS unsigned char* P_lds = lds + L_KPE;
    LAS float* bias_l = (LAS float*)(lds + L_BIAS); LAS float* tab_l = (LAS float*)(lds + L_TAB);
    LAS float* wsf = (LAS float*)(lds + L_WS) + wid * 64; LAS float* li_l = wsf; LAS float* al_l = wsf + 32;
    LAS unsigned* need_l = (LAS unsigned*)(lds + L_NEED);
    const bf16_t* Qg = a.q + (rowbase + q0 + wid * QBLK + r32) * (size_t)a.ldq + h * HD;
    const bf16_t* Kg = a.k + rowbase * (size_t)a.ldk + h * HD;
    const bf16_t* Vg = a.v + rowbase * (size_t)a.ldv + h * HD;
    bf16x8 qr[MODE == MLA ? 12 : 8];
#pragma unroll
    for (int d0 = 0; d0 < 8; ++d0) qr[d0] = *(const bf16x8*)(Qg + d0 * 16 + hi * 8);
    if constexpr (MODE == MLA) { const bf16_t* Qr = a.qr + (rowbase + q0 + wid * QBLK + r32) * (size_t)a.ldq + h * 64;
#pragma unroll
        for (int d0 = 0; d0 < 4; ++d0) qr[8 + d0] = *(const bf16x8*)(Qr + d0 * 16 + hi * 8); }
    int koff[2], voff[2], poff = 0;
#pragma unroll
    for (int j = 0; j < 2; ++j) { const int pc = wid * 2 + j;
        { const int row = pc * 4 + (lane >> 4), ch = (lane & 15) ^ (row & 7); koff[j] = row * a.ldk + ch * 8; }
        { const int st = pc * 2 + (lane >> 5), kk = (st >> 2) * 8 + ((lane & 31) >> 2), c = (st & 3) * 32 + (lane & 3) * 8; const int k = (kk & ~0xC) | ((kk & 4) << 1) | ((kk & 8) >> 1); voff[j] = k * a.ldv + c; } }
    if constexpr (MODE == MLA) { const int row = wid * 8 + (lane >> 3), ch = (lane & 7) ^ (row & 7); poff = row * 64 + ch * 8; }
    const int vb0 = (int)(uintptr_t)V_lds + v_rd_base(lane);
    const LAS unsigned char* kb4[4];
#pragma unroll
    for (int dd = 0; dd < 4; ++dd) kb4[dd] = K_lds + KSWZ(r32, (dd * 16 + hi * 8) * 2);
    const LAS unsigned char* pb4[4];
#pragma unroll
    for (int dd = 0; dd < 4; ++dd) pb4[dd] = P_lds + r32 * 128 + (((dd * 2 + hi) * 16) ^ ((r32 & 7) << 4));
    const int NBLK = qb + 1;
    unsigned need = (1u << NBLK) - 1u; unsigned selmask = need;
    float sl2 = 0.f;
    if constexpr (MODE == MOBA) {
        sl2 = __builtin_amdgcn_exp2f(-(float)(h + 1)) * LOG2E;
        if (tid < 64) tab_l[tid] = sl2 * (float)tid;
        if (tid == 0) need_l[0] = 0u;
        { const int sr = tid >> 4, sc = (tid & 15) * 8, kws = KSWZ(sr, sc * 2);
          const size_t kmoff = ((size_t)(b * NHEAD + h) * 16) * HD; u32x4 z;
#pragma unroll
          for (int j = 0; j < 4; ++j) { unsigned z_; asm volatile("v_mov_b32 %0, 0" : "=v"(z_)); z[j] = z_; }
          if (tid < 256) { *(LAS u32x4*)(K_lds + kws) = *(const u32x4*)(a.kmh + kmoff + (size_t)sr * HD + sc); *(LAS u32x4*)(K_lds + SHM_K + kws) = *(const u32x4*)(a.kml + kmoff + (size_t)sr * HD + sc); }
          else { *(LAS u32x4*)(K_lds + kws) = z; *(LAS u32x4*)(K_lds + SHM_K + kws) = z; } }
        __syncthreads();
        f32x16 g = {};
#pragma unroll
        for (int d0 = 0; d0 < 8; ++d0) { const LAS unsigned char* ap = kb4[d0 & 3] + (d0 >> 2) * 128;
            const bf16x8 kh = *(const LAS bf16x8*)ap, kl = *(const LAS bf16x8*)(ap + SHM_K);
            g = __builtin_amdgcn_mfma_f32_32x32x16_bf16(kh, qr[d0], g, 0, 0, 0); g = __builtin_amdgcn_mfma_f32_32x32x16_bf16(kl, qr[d0], g, 0, 0, 0); }
        float val[16];
#pragma unroll
        for (int i = 0; i < 8; ++i) { auto rr = __builtin_amdgcn_permlane32_swap(__float_as_uint(g[i]), __float_as_uint(g[i]), false, false);
            const int nlo = (i & 3) + 8 * (i >> 2); val[nlo] = __uint_as_float(rr[0]); val[nlo + 4] = __uint_as_float(rr[1]); }
        const float NEGI = -__builtin_inff();
#pragma unroll
        for (int n = 0; n < 16; ++n) if (n >= qb) val[n] = NEGI;
        unsigned sel = 0u;
#pragma unroll
        for (int pass = 0; pass < 3; ++pass) { float best = NEGI; int bi = -1;
#pragma unroll
            for (int n = 0; n < 16; ++n) if (val[n] > best) { best = val[n]; bi = n; }
#pragma unroll
            for (int n = 0; n < 16; ++n) if (n == bi) { val[n] = NEGI; sel |= (1u << n); } }
        selmask = sel | (1u << qb);
        unsigned wneed = 0u;
#pragma unroll
        for (int n = 0; n < 16; ++n) if (__ballot((selmask >> n) & 1u) != 0ull) wneed |= (1u << n);
        if (lane == 0) atomicOr((unsigned*)need_l, wneed);
        __syncthreads();
        need = (unsigned)__builtin_amdgcn_readfirstlane((int)need_l[0]);
    }
    LAS float* pkn_l = (LAS float*)(lds + L_PKN); LAS unsigned* dead_l = (LAS unsigned*)(lds + L_DEAD);
    float qn = 0.f; bool wdead = false; bool fin = false;
    if constexpr (MODE != MLA) {
        if (wid == 0) { float t = a.tkn[(size_t)(b * NHEAD + h) * 64 + lane];
#pragma unroll
            for (int o_ = 1; o_ < 64; o_ <<= 1) { const float u_ = __int_as_float(__builtin_amdgcn_ds_bpermute(((lane - o_) & 63) << 2, __float_as_int(t))); if (lane >= o_) t = fmaxf(t, u_); }
            pkn_l[lane] = t; if (lane == 0) dead_l[0] = 0u; }
        float ss = 0.f;
#pragma unroll
        for (int d0 = 0; d0 < 8; ++d0) { const u32x4 w = __builtin_bit_cast(u32x4, qr[d0]);
#pragma unroll
            for (int j = 0; j < 4; ++j) { const float lo = bf_lo(w[j]), hi_ = bf_hi(w[j]); ss += lo * lo + hi_ * hi_; } }
        ss = sum_xor32(ss); qn = sqrtf(ss) * 1.000001f;
    }
    float m_reg = -1e30f, l_reg = 0.f; f32x16 o[4] = {};
    const int qpos = q0 + wid * QBLK + r32;
    const int qlo = q0 + wid * QBLK;
    const LAS float* bt = (MODE == FOX) ? (const LAS float*)(bias_l + 4 * hi) : (const LAS float*)(tab_l + 4 * hi);
#define T_DMA(kb, BUFN) do { \
        _Pragma("unroll") for (int j_ = 0; j_ < 2; ++j_) { \
            __builtin_amdgcn_global_load_lds((const unsigned*)(Kg + (size_t)(kb) * a.ldk + koff[j_]), (LAS unsigned*)(K_lds + (BUFN) * SHM_K + (wid * 2 + j_) * 1024), 16, 0, 0); \
            __builtin_amdgcn_global_load_lds((const unsigned*)(Vg + (size_t)(kb) * a.ldv + voff[j_]), (LAS unsigned*)(V_lds + (BUFN) * SHM_V + (wid * 2 + j_) * 1024), 16, 0, 0); } \
        if constexpr (MODE == MLA) __builtin_amdgcn_global_load_lds((const unsigned*)(a.kr + (rowbase + (kb)) * 64 + poff), (LAS unsigned*)(P_lds + (BUFN) * SHM_KPE + wid * 1024), 16, 0, 0); \
        if constexpr (MODE == FOX) { if (wid == 0) __builtin_amdgcn_global_load_lds((const unsigned*)(a.cb + (size_t)(b * NHEAD + h) * SEQ + (kb) + lane), (LAS unsigned*)(bias_l + (BUFN) * 64), 4, 0, 0); } } while (0)
#define PK4(P, B_, OUT) do { unsigned a0_ = cvt_pk_bf16(P[B_ + 0], P[B_ + 1]), a1_ = cvt_pk_bf16(P[B_ + 2], P[B_ + 3]), b0_ = cvt_pk_bf16(P[B_ + 4], P[B_ + 5]), b1_ = cvt_pk_bf16(P[B_ + 6], P[B_ + 7]); \
        auto r0_ = __builtin_amdgcn_permlane32_swap(a0_, b0_, false, false); auto r1_ = __builtin_amdgcn_permlane32_swap(a1_, b1_, false, false); \
        u32x4 w_ = {r0_[0], r1_[0], r0_[1], r1_[1]}; OUT = __builtin_bit_cast(bf16x8, w_); } while (0)
#define TRRD(dst, off_) asm volatile("ds_read_b64_tr_b16 %0, %1 offset:%2" : "=&v"(dst) : "v"(vb0), "i"(off_) : "memory")
#define PV_D0(BUF, d0) do { s16x4 l0, l1, l2, l3, h0, h1, h2, h3; constexpr int b_ = (BUF) * SHM_V + (d0) * 512; \
        TRRD(l0, b_); TRRD(h0, b_ + 2048); TRRD(l1, b_ + 4096); TRRD(h1, b_ + 6144); TRRD(l2, b_ + 8192); TRRD(h2, b_ + 10240); TRRD(l3, b_ + 12288); TRRD(h3, b_ + 14336); \
        asm volatile("s_waitcnt lgkmcnt(0)" ::: "memory"); SBAR(); \
        o[d0] = __builtin_amdgcn_mfma_f32_32x32x16_bf16(pa0, (bf16x8){l0[0], l0[1], l0[2], l0[3], h0[0], h0[1], h0[2], h0[3]}, o[d0], 0, 0, 0); \
        o[d0] = __builtin_amdgcn_mfma_f32_32x32x16_bf16(pa1, (bf16x8){l1[0], l1[1], l1[2], l1[3], h1[0], h1[1], h1[2], h1[3]}, o[d0], 0, 0, 0); \
        o[d0] = __builtin_amdgcn_mfma_f32_32x32x16_bf16(pa2, (bf16x8){l2[0], l2[1], l2[2], l2[3], h2[0], h2[1], h2[2], h2[3]}, o[d0], 0, 0, 0); \
        o[d0] = __builtin_amdgcn_mfma_f32_32x32x16_bf16(pa3, (bf16x8){l3[0], l3[1], l3[2], l3[3], h3[0], h3[1], h3[2], h3[3]}, o[d0], 0, 0, 0); } while (0)
#define TILE(BUF, kb_, HASN, nkb_) do { const int kb = (kb_); \
        if (HASN) T_DMA((nkb_), (BUF) ^ 1); \
        SBAR(); \
        f32x16 p0, p1; \
        if constexpr (MODE == MLA) { p0 = f32x16{}; p1 = f32x16{}; } \
        else { const LAS float* btb = bt + (MODE == FOX ? (BUF) * 64 : 0); \
            _Pragma("unroll") for (int gq = 0; gq < 4; ++gq) { const f32x4 b0 = *(const LAS f32x4*)(btb + 8 * gq), b1 = *(const LAS f32x4*)(btb + 32 + 8 * gq); \
                _Pragma("unroll") for (int j = 0; j < 4; ++j) { p0[4 * gq + j] = b0[j]; p1[4 * gq + j] = b1[j]; } } } \
        _Pragma("unroll") for (int d0 = 0; d0 < 8; ++d0) { const LAS unsigned char* ap = kb4[d0 & 3] + (d0 >> 2) * 128 + (BUF) * SHM_K; \
            const bf16x8 k0 = *(const LAS bf16x8*)ap, k1 = *(const LAS bf16x8*)(ap + 32 * 256); \
            p0 = __builtin_amdgcn_mfma_f32_32x32x16_bf16(k0, qr[d0], p0, 0, 0, 0); p1 = __builtin_amdgcn_mfma_f32_32x32x16_bf16(k1, qr[d0], p1, 0, 0, 0); } \
        if constexpr (MODE == MLA) { \
            _Pragma("unroll") for (int d0 = 0; d0 < 4; ++d0) { const LAS unsigned char* ap = pb4[d0] + (BUF) * SHM_KPE; \
                const bf16x8 k0 = *(const LAS bf16x8*)ap, k1 = *(const LAS bf16x8*)(ap + 32 * 128); \
                p0 = __builtin_amdgcn_mfma_f32_32x32x16_bf16(k0, qr[8 + d0], p0, 0, 0, 0); p1 = __builtin_amdgcn_mfma_f32_32x32x16_bf16(k1, qr[8 + d0], p1, 0, 0, 0); } } \
        const float NEG = -__builtin_inff(); \
        if (blk == qb && kb + KVBLK - 1 > qlo) { const int dq = qpos - kb - 4 * hi; \
            _Pragma("unroll") for (int r = 0; r < 16; ++r) { const int c = (r & 3) + 8 * (r >> 2); if (dq - c < 0) p0[r] = NEG; if (dq - c - 32 < 0) p1[r] = NEG; } } \
        if constexpr (MODE == MOBA) { if (((selmask >> blk) & 1u) == 0u) { \
            _Pragma("unroll") for (int r = 0; r < 16; ++r) { p0[r] = NEG; p1[r] = NEG; } } } \
        float aoff = 0.f; if constexpr (MODE == MOBA) aoff = sl2 * (float)(kb - qpos); \
        float pmax = p0[0]; \
        _Pragma("unroll") for (int r = 1; r < 16; ++r) pmax = fmaxf(pmax, p0[r]); \
        _Pragma("unroll") for (int r = 0; r < 16; ++r) pmax = fmaxf(pmax, p1[r]); \
        { auto rr = __builtin_amdgcn_permlane32_swap(__float_as_uint(pmax), __float_as_uint(pmax), false, false); pmax = fmaxf(__uint_as_float(rr[0]), __uint_as_float(rr[1])); } \
        pmax += aoff; \
          \
        const bool dead_ = (MODE != MLA) && __all(pmax - m_reg < -150.f); \
        if (!dead_) { \
        float alpha = 1.f; \
        if (!__all(pmax - m_reg <= THRL)) { const float mn = fmaxf(m_reg, pmax); alpha = __builtin_amdgcn_exp2f(m_reg - mn); m_reg = mn; } \
        const float off = aoff - m_reg; \
        _Pragma("unroll") for (int r = 0; r < 16; ++r) { p0[r] = __builtin_amdgcn_exp2f(p0[r] + off); p1[r] = __builtin_amdgcn_exp2f(p1[r] + off); } \
        float ps = 0.f; \
        _Pragma("unroll") for (int r = 0; r < 16; ++r) ps += p0[r]; \
        _Pragma("unroll") for (int r = 0; r < 16; ++r) ps += p1[r]; \
        { auto rr = __builtin_amdgcn_permlane32_swap(__float_as_uint(ps), __float_as_uint(ps), false, false); ps = __uint_as_float(rr[0]) + __uint_as_float(rr[1]); } \
        l_reg = l_reg * alpha + ps; \
        bf16x8 pa0, pa1, pa2, pa3; \
        PK4(p0, 0, pa0); PK4(p0, 8, pa1); PK4(p1, 0, pa2); PK4(p1, 8, pa3); \
        if (__any(alpha < 1.f)) { if (hi == 0) al_l[r32] = alpha; LDS_WAIT(); \
            _Pragma("unroll") for (int d_ = 0; d_ < 4; ++d_) _Pragma("unroll") for (int r = 0; r < 16; ++r) o[d_][r] *= al_l[crow(r, hi)]; } \
        PV_D0(BUF, 0); PV_D0(BUF, 1); PV_D0(BUF, 2); PV_D0(BUF, 3); } \
        if constexpr (MODE != MLA) { if ((HASN) && !wdead && kb >= KVBLK) { \
            const float brem_ = (MODE == FOX) ? bias_l[(BUF) * 64] : aoff; \
            if (__all(qn * pkn_l[(kb >> 6) - 1] + brem_ - m_reg < -140.f)) { wdead = true; if (lane == 0) atomicAdd((unsigned*)dead_l, 1u); } } } \
        if (HASN) { VM_WAIT(); __syncthreads(); if constexpr (MODE != MLA) fin = (__builtin_amdgcn_readfirstlane((int)dead_l[0]) >= NW_ATT); } } while (0)
    int blk = 31 - __builtin_clz(need);
    T_DMA(blk * 256 + 192, 0); VM_WAIT(); __syncthreads();
    for (;;) {
        const unsigned rest = need & ((1u << blk) - 1u); const bool more = rest != 0u; const int nblk = more ? 31 - __builtin_clz(rest) : blk;
        TILE(0, blk * 256 + 192, true, blk * 256 + 128); if (fin) break;
        TILE(1, blk * 256 + 128, true, blk * 256 + 64); if (fin) break;
        TILE(0, blk * 256 + 64, true, blk * 256); if (fin) break;
        TILE(1, blk * 256, more, nblk * 256 + 192);
        if (!more || fin) break;
        blk = nblk;
    }
#undef TILE
#undef PV_D0
#undef TRRD
#undef PK4
#undef T_DMA
    __syncthreads();
    if (hi == 0) li_l[r32] = l_reg; LDS_WAIT();
    LAS bf16_t* stg = (LAS bf16_t*)(lds + L_OST) + wid * 4096;
#pragma unroll
    for (int r = 0; r < 16; ++r) { const int orow = crow(r, hi); const float rl = __builtin_amdgcn_rcpf(li_l[orow]);
#pragma unroll
        for (int d0 = 0; d0 < 4; ++d0) { const float v = o[d0][r] * rl; const unsigned u = __float_as_uint(v); stg[orow * 128 + d0 * 32 + r32] = (bf16_t)((u + 0x7fffu + ((u >> 16) & 1u)) >> 16); } }
    LDS_WAIT();
    bf16_t* Og = a.o + (rowbase + q0 + wid * QBLK) * (size_t)NOATT + h * HD;
#pragma unroll
    for (int i = 0; i < 8; ++i) { const int row = i * 4 + (lane >> 4), ch = lane & 15; const u32x4 v = *(const LAS u32x4*)(stg + row * 128 + ch * 8); *(u32x4*)(Og + (size_t)row * NOATT + ch * 8) = v; }
    __syncthreads();
}
}

#define XB_TMO      128
#define XB_XCNT(j)  (256  + 64 * (j))
#define XB_XSUB(j)  (1280 + 64 * (j))
#define XB_XGEN(j)  (2304 + 64 * (j))
#define XB_TOP      3328
#define XB_TOPGEN   3392
#define XCD_BAR_WORDS 3456
#define XB_SPIN_CAP (1u << 22)
__device__ __forceinline__ unsigned xb_ld(unsigned* p)              { return __hip_atomic_load(p, __ATOMIC_RELAXED, __HIP_MEMORY_SCOPE_AGENT); }
__device__ __forceinline__ unsigned xb_add(unsigned* p, unsigned v) { return __hip_atomic_fetch_add(p, v, __ATOMIC_RELAXED, __HIP_MEMORY_SCOPE_AGENT); }
__device__ __forceinline__ unsigned xb_xcc_id() { return (unsigned)__builtin_amdgcn_s_getreg((3 << 11) | 20) & 0xFu; }
#define XB_SPIN(cond, bar) do { unsigned _sp = 0; while (cond) { __builtin_amdgcn_s_sleep(1); \
    if ((++_sp & 255u) == 0u) { if (xb_ld(&(bar)[XB_TMO])) break; if (_sp > XB_SPIN_CAP) { atomicAdd(&(bar)[XB_TMO], 1u); break; } } } } while (0)
struct XcdBarrier { unsigned* bar; unsigned x; volatile LAS unsigned* st; };
__device__ __forceinline__ XcdBarrier xcd_barrier_post(unsigned* bar, volatile LAS unsigned* st) {
    XcdBarrier b; b.bar = bar; b.x = xb_xcc_id(); b.st = st;
    if (threadIdx.x == 0) (void)xb_add(&bar[XB_XCNT(b.x)], 1u);
    return b;
}
__device__ __forceinline__ void xcd_barrier_complete(unsigned* bar, unsigned x, unsigned& nloc, unsigned& nx) {
    const unsigned G = gridDim.x * gridDim.y * gridDim.z;
    unsigned sum, cnt, mine, sp = 0u;
    for (;;) {
        sum = 0u; cnt = 0u; mine = 0u;
#pragma unroll
        for (unsigned j = 0; j < 16; ++j) { const unsigned c = xb_ld(&bar[XB_XCNT(j)]); sum += c; cnt += (c > 0u) ? 1u : 0u; mine = (j == x) ? c : mine; }
        if (sum == G) break;
        __builtin_amdgcn_s_sleep(1);
        if ((++sp & 255u) == 0u) { if (xb_ld(&bar[XB_TMO])) break; if (sp > XB_SPIN_CAP) { atomicAdd(&bar[XB_TMO], 1u); break; } }
    }
    nloc = mine > 0u ? mine : 1u; nx = cnt > 0u ? cnt : 1u;
}
__device__ __forceinline__ void xcd_barrier(const XcdBarrier& b, int tidx) {
    asm volatile("s_waitcnt vmcnt(0)" ::: "memory");
    __syncthreads();
    if (tidx == 0) {
        unsigned* bar = b.bar;
        __builtin_amdgcn_s_waitcnt(0);
        unsigned nloc = b.st[0], nx = b.st[1];
        if (nloc == 0u) { xcd_barrier_complete(bar, b.x, nloc, nx); b.st[0] = nloc; b.st[1] = nx; }
        const unsigned old = xb_add(&bar[XB_XSUB(b.x)], 1u);
        const unsigned gen = old / nloc;
        if (old + 1u == (gen + 1u) * nloc) {
            __builtin_amdgcn_fence(__ATOMIC_RELEASE, "agent");
            asm volatile("s_waitcnt vmcnt(0)" ::: "memory");
            const unsigned og = xb_add(&bar[XB_TOP], 1u);
            const unsigned tg = og / nx;
            if (og + 1u == (tg + 1u) * nx) xb_add(&bar[XB_TOPGEN], 1u);
            else XB_SPIN(xb_ld(&bar[XB_TOPGEN]) == tg, bar);
            __builtin_amdgcn_fence(__ATOMIC_ACQUIRE, "agent");
            xb_add(&bar[XB_XGEN(b.x)], 1u);
            asm volatile("s_waitcnt vmcnt(0)" ::: "memory");
        } else {
            XB_SPIN(xb_ld(&bar[XB_XGEN(b.x)]) == gen, bar);
            __builtin_amdgcn_fence(__ATOMIC_ACQUIRE, "agent");
            asm volatile("s_waitcnt vmcnt(0)" ::: "memory");
        }
    }
    __syncthreads();
}

struct KArgs {
    const float* x; const int* pos; const float* w_in; const float* b_forget; const float* g_q_a; const float* g_kv_a; const float* w_q_b; const float* w_kv_b;
    const float* w_br[3]; const float* w_o; const float* ln1_g; const float* ln1_b; const float* ln2_g; const float* ln2_b;
    const float* ffn_w1; const float* ffn_w3; const float* ffn_w2; const float* moe_router; const float* moe_w1; const float* moe_w3; const float* moe_w2;
    float* out; unsigned char* ws; int ph_lo, ph_hi;
};

__constant__ double ROPE_INV[32] = {1.0, 0.7498942093324559, 0.5623413251903491, 0.4216965034285822, 0.31622776601683794, 0.23713737056616552, 0.1778279410038923, 0.1333521432163324,
    0.09999999999999999, 0.07498942093324558, 0.056234132519034905, 0.042169650342858224, 0.03162277660168379, 0.023713737056616554, 0.01778279410038923, 0.013335214321633239,
    0.01, 0.007498942093324559, 0.005623413251903491, 0.004216965034285822, 0.0031622776601683794, 0.002371373705661655, 0.0017782794100389228, 0.0013335214321633238,
    0.001, 0.0007498942093324559, 0.000562341325190349, 0.00042169650342858224, 0.00031622776601683794, 0.00023713737056616554, 0.0001778279410038923, 0.0001333521432163324};

enum { MAP_ID = 0, MAP_WIN = 1, MAP_WQB = 2, MAP_WKVB = 3, MAP_GLU = 4, MAP_WING = 5 };
template <int MAPK>
__device__ __forceinline__ int src_col(int n, int& which) {
    which = 0;
    if constexpr (MAPK == MAP_ID) return n;
    if constexpr (MAPK == MAP_WIN) {
        if (n < C_CQ) return n;
        if (n < C_CKV) return SRC_CQ + (n - C_CQ);
        if (n < C_GATE) return SRC_CKV + (n - C_CKV);
        const int j = n - C_GATE;
        if (j < 64) { const int i = j >> 1; return SRC_KROPE + ((j & 1) ? 32 + i : i); }
        if (j < 72) return SRC_FORGET + (j - 64);
        return -1;
    }
    if constexpr (MAPK == MAP_WING) return SRC_GATE + n;
    if constexpr (MAPK == MAP_WQB) {
        if (n < 1024) { const int hh = n >> 7, d = n & 127; return hh * 192 + d; }
        const int j = n - 1024, hh = j >> 6, jj = j & 63, i = jj >> 1; return hh * 192 + 128 + ((jj & 1) ? 32 + i : i);
    }
    if constexpr (MAPK == MAP_WKVB) { const int hh = (n & 1023) >> 7, d = n & 127; return hh * 256 + (n >= 1024 ? 128 : 0) + d; }
    if constexpr (MAPK == MAP_GLU) { const int t = n >> 8, c = n & 255; which = (c >= 128) ? 1 : 0; return t * 128 + (c & 127); }
    return n;
}
template <int MAPK>
__device__ __forceinline__ void transpose_item(const float* W, const float* W2, const float* kscale, int K, int Nsrc, bf16_t* WT, LAS float* scr, int item, int nblk, int lane) {
    const int kb = item / nblk, nb = item % nblk, k0 = 64 * kb, n0 = 32 * nb;
    int which; const int scol = src_col<MAPK>(n0 + (lane & 31), which); const float* Ws = which ? W2 : W;
    const int scolc = scol >= 0 ? scol : 0; const float colm = scol >= 0 ? 1.f : 0.f;
    float v[32];
#pragma unroll
    for (int i = 0; i < 32; ++i) { const int kk = 2 * i + (lane >> 5); v[i] = Ws[(size_t)(k0 + kk) * Nsrc + scolc] * colm; }
#pragma unroll
    for (int i = 0; i < 32; ++i) { const int kk = 2 * i + (lane >> 5); float x = v[i]; if (kscale) x *= kscale[k0 + kk]; scr[kk * 33 + (lane & 31)] = x; }
    LDS_WAIT(); asm volatile("" ::: "memory");
    const int c = lane & 7;
#pragma unroll
    for (int j = 0; j < 4; ++j) { const int n = (lane >> 3) + 8 * j; const LAS float* s = scr + (8 * c) * 33 + n;
        u32x4 o; o.x = cvt_pk_bf16(s[0 * 33], s[1 * 33]); o.y = cvt_pk_bf16(s[2 * 33], s[3 * 33]); o.z = cvt_pk_bf16(s[4 * 33], s[5 * 33]); o.w = cvt_pk_bf16(s[6 * 33], s[7 * 33]);
        *(u32x4*)(WT + (size_t)(n0 + n) * K + k0 + 8 * c) = o; }
    LDS_WAIT(); asm volatile("" ::: "memory");
}
template <int MAPK>
__device__ __forceinline__ void transpose_item_f8(const float* W, const float* W2, float wscale, int K, int Nsrc, unsigned char* WT, LAS float* scr, int item, int nblk, int lane) {
    const int kb = item / nblk, nb = item % nblk, k0 = 64 * kb, n0 = 32 * nb;
    int which; const int scol = src_col<MAPK>(n0 + (lane & 31), which); const float* Ws = which ? W2 : W;
    const int scolc = scol >= 0 ? scol : 0; const float colm = scol >= 0 ? 1.f : 0.f;
    float v[32];
#pragma unroll
    for (int i = 0; i < 32; ++i) { const int kk = 2 * i + (lane >> 5); v[i] = Ws[(size_t)(k0 + kk) * Nsrc + scolc] * colm; }
#pragma unroll
    for (int i = 0; i < 32; ++i) { const int kk = 2 * i + (lane >> 5); scr[kk * 33 + (lane & 31)] = v[i] * wscale; }
    LDS_WAIT(); asm volatile("" ::: "memory");
    const int c = lane & 3;
#pragma unroll
    for (int j = 0; j < 2; ++j) { const int n = (lane >> 2) + 16 * j; const LAS float* sp = scr + (16 * c) * 33 + n;
        u32x4 o; o.x = pk4_fp8(sp[0 * 33], sp[1 * 33], sp[2 * 33], sp[3 * 33]); o.y = pk4_fp8(sp[4 * 33], sp[5 * 33], sp[6 * 33], sp[7 * 33]);
        o.z = pk4_fp8(sp[8 * 33], sp[9 * 33], sp[10 * 33], sp[11 * 33]); o.w = pk4_fp8(sp[12 * 33], sp[13 * 33], sp[14 * 33], sp[15 * 33]);
        *(u32x4*)(WT + (size_t)(n0 + n) * K + k0 + 16 * c) = o; }
    LDS_WAIT(); asm volatile("" ::: "memory");
}
template <int MAPK>
__device__ __forceinline__ void transpose_matrix_f8(const float* W, const float* W2, float wscale, int K, int Nsrc, int Ndst, unsigned char* WT, LAS float* scr, int gw, int NGW, int lane) {
    const int nblk = Ndst / 32, nitems = (K / 64) * nblk;
    for (int it = gw; it < nitems; it += NGW) transpose_item_f8<MAPK>(W, W2, wscale, K, Nsrc, WT, scr, it, nblk, lane);
}
template <int MAPK>
__device__ __forceinline__ void transpose_matrix(const float* W, const float* W2, const float* kscale, int K, int Nsrc, int Ndst, bf16_t* WT, LAS float* scr, int gw, int NGW, int lane) {
    const int nblk = Ndst / 32, nitems = (K / 64) * nblk;
    for (int it = gw; it < nitems; it += NGW) transpose_item<MAPK>(W, W2, kscale, K, Nsrc, WT, scr, it, nblk, lane);
}

#define LNC(j) (2 * (lane + 64 * ((j) >> 1)) + ((j) & 1))
__device__ __forceinline__ void ln_row(f32x4 (&v)[8], const float* g, const float* bta, int lane) {
    float s = 0.f;
#pragma unroll
    for (int j = 0; j < 8; ++j) s += (v[j][0] + v[j][1]) + (v[j][2] + v[j][3]);
    const float mean = wave_sum(s) * (1.f / DM); float s2 = 0.f;
#pragma unroll
    for (int j = 0; j < 8; ++j) { v[j] = v[j] - mean; s2 += (v[j][0] * v[j][0] + v[j][1] * v[j][1]) + (v[j][2] * v[j][2] + v[j][3] * v[j][3]); }
    const float rstd = 1.f / sqrtf(wave_sum(s2) * (1.f / DM) + LN_EPS);
#pragma unroll
    for (int j = 0; j < 8; ++j) { const f32x4 gg = *(const f32x4*)(g + 4 * LNC(j)), bb = *(const f32x4*)(bta + 4 * LNC(j)); v[j] = v[j] * rstd * gg + bb; }
}

__device__ __forceinline__ bool ph_in(int lo, int hi, int k) { asm volatile("" : "+s"(lo), "+s"(hi)); return lo <= k && k < hi; }
#define PHASE_PTRS() GAS unsigned char* ws0_ = (GAS unsigned char*)args.ws; asm volatile("" : "+s"(ws0_)); unsigned char* ws = (unsigned char*)ws0_;     \
    unsigned* ctl = (unsigned*)(ws + WS_CTL); (void)ctl; \
    int bx = blockIdx.x, G = gridDim.x; asm volatile("" : "+s"(bx), "+s"(G)); const int vcu = (G % 8 == 0) ? (bx % 8) * (G / 8) + bx / 8 : bx; const int NGW = G * NWAVES; (void)vcu; (void)NGW; \
    float* cosT = (float*)(ws + WS_COS); float* sinT = (float*)(ws + WS_SIN); float* ssq = (float*)(ws + WS_SSQ); float* lf = (float*)(ws + WS_LF); float* cb = (float*)(ws + WS_CB); \
    bf16_t* kmh = (bf16_t*)(ws + WS_KMH); bf16_t* kml = (bf16_t*)(ws + WS_KML); bf16_t* kpe = (bf16_t*)(ws + WS_KPE); \
    int* ltok = (int*)(ws + WS_LTOK); int* ldst = (int*)(ws + WS_LDST); float* lgate = (float*)(ws + WS_LGATE); \
    bf16_t* XB = (bf16_t*)(ws + WS_XB); bf16_t* X1 = (bf16_t*)(ws + WS_X1); bf16_t* PROJ = (bf16_t*)(ws + WS_PROJ); bf16_t* QM = (bf16_t*)(ws + WS_QM); bf16_t* KVM = (bf16_t*)(ws + WS_KVM); \
    bf16_t* OATT = (bf16_t*)(ws + WS_OATT); bf16_t* MERGED = (bf16_t*)(ws + WS_MERGED); bf16_t* Y = (bf16_t*)(ws + WS_Y); bf16_t* HID = (bf16_t*)(ws + WS_HID); bf16_t* YMOE = (bf16_t*)(ws + WS_YMOE); unsigned char* XGFR = ws + WS_XGFR; \
    (void)cosT; (void)sinT; (void)ssq; (void)lf; (void)cb; (void)kmh; (void)kml; (void)kpe; (void)ltok; (void)ldst; (void)lgate; (void)XB; (void)X1; (void)PROJ; (void)QM; (void)KVM; (void)OATT; (void)MERGED; (void)Y; (void)HID; (void)YMOE; (void)XGFR;
#define MOE_COUNTS() int cnt[8], tb[9]; tb[0] = 0; \
    _Pragma("unroll") for (int e = 0; e < 8; ++e) { cnt[e] = __builtin_amdgcn_readfirstlane((int)__hip_atomic_load(ctl + CW_CNT + e, RLX_AGENT)); if (cnt[e] > MTOK) cnt[e] = MTOK; tb[e + 1] = tb[e] + ((cnt[e] + 255) >> 8); }
#define OPAQUE_IDS() int tid = my_tid(wave0); const int lane = tid & 63, wave = __builtin_amdgcn_readfirstlane(tid >> 6); const int gw = vcu * NWAVES + wave; (void)lane; (void)gw;
constexpr int PH_PER_LAYER = 10, N_PHASES = 1 + 2 * PH_PER_LAYER;
#define IN(k) ph_in(lo, hi, (k))
#define SEAM(k) do { if (IN(k) && IN((k) + 1)) { XcdBarrier b_; b_.bar = (unsigned*)(args.ws + WS_CTL) + CW_BAR; b_.x = xb_xcc_id(); b_.st = MISC + 8; xcd_barrier(b_, my_tid(wave0)); } } while (0)
struct LArgs { const float* b_forget; const float* ln1_g; const float* ln1_b; const float* ln2_g; const float* ln2_b; const float* moe_router; float* out; unsigned char* ws; };
template <int l>
__device__ __forceinline__ void layer_fn(const LArgs args, LAS unsigned char* ldsL, volatile LAS unsigned* MISC, const int wave0, const int lo, const int hi) {
        const int P = 1 + l * PH_PER_LAYER;
        for (int rep_ = 0; rep_ < NREP(0); ++rep_) if (IN(P + 0) && EN(0)) {
            PHASE_PTRS();
            pg8::Shape g{DM, DM, DM};
            SchedPlain S{64, 29, G, bx, (unsigned)WS_XB, (unsigned)(WS_WIN + (size_t)l * NWIN16 * DM * 2), 256u * DM * 2, 256u * DM * 2};
            EpiInProj E{PROJ, ssq, cosT, sinT, kpe, lf, args.b_forget + l * 8};
            pg8::gemm_phase(ldsL, (const char*)ws, wave0, g, S, E);
            pg8::Shape g8{DM / 2, DM / 2, DM / 2};
            SchedGates S8{G, bx, (unsigned)WS_XBF, (unsigned)(WS_WINF + (size_t)l * 6144 * DM)};
            EpiGates8 E8{PROJ};
            pg8::gemm_phase<EpiGates8, SchedGates, true>(ldsL, (const char*)ws, wave0, g8, S8, E8);
        }
        SEAM(P + 0);
        for (int rep_ = 0; rep_ < NREP(1); ++rep_) if (IN(P + 1) && EN(1)) {
            PHASE_PTRS();
            { OPAQUE_IDS();
            if (gw < 32) {
                const int b = gw >> 3, h = gw & 7; float carry = 0.f;
                for (int j = 0; j < 64; ++j) { const int s = j * 64 + lane; float v = lf[((size_t)b * SEQ + s) * 8 + h];
#pragma unroll
                    for (int o = 1; o < 64; o <<= 1) { const float t = __int_as_float(__builtin_amdgcn_ds_bpermute(((lane - o) & 63) << 2, __float_as_int(v))); if (lane >= o) v += t; }
                    cb[(size_t)gw * SEQ + s] = -(carry + v) * LOG2E; carry += __int_as_float(__builtin_amdgcn_readlane(__float_as_int(v), 63)); }
            } else if (gw < 32 + 512) {
                const int it = gw - 32, bh = it >> 4, n = it & 15, b = bh >> 3, h = bh & 7;
                const bf16_t* kp = PROJ + ((size_t)b * SEQ + n * 256) * NPROJ + C_MOBA + 1024 + h * HD + 2 * lane; float s0 = 0.f, s1 = 0.f;
#pragma unroll 16
                for (int r = 0; r < 256; ++r) { const unsigned w = *(const unsigned*)(kp + (size_t)r * NPROJ); s0 += bf_lo(w); s1 += bf_hi(w); }
                s0 *= (1.f / 256.f); s1 *= (1.f / 256.f);
                const unsigned hw = cvt_pk_bf16(s0, s1); const unsigned lw = cvt_pk_bf16(s0 - bf_lo(hw), s1 - bf_hi(hw));
                *(unsigned*)(kmh + (size_t)it * HD + 2 * lane) = hw; *(unsigned*)(kml + (size_t)it * HD + 2 * lane) = lw;
            }
            for (int it = gw; it < 4096; it += NGW) { const int br = it >> 11, bh = (it >> 6) & 31, t = it & 63, b = bh >> 3, h = bh & 7;
                const u32x4* kp = (const u32x4*)(PROJ + ((size_t)b * SEQ + t * 64 + lane) * NPROJ + (br ? C_FOX : C_MOBA) + 1024 + h * HD); float ss = 0.f;
#pragma unroll
                for (int c = 0; c < 16; ++c) { const u32x4 w = kp[c];
#pragma unroll
                    for (int j = 0; j < 4; ++j) { const float lo = bf_lo(w[j]), hi_ = bf_hi(w[j]); ss += lo * lo + hi_ * hi_; } }
                float nm = sqrtf(ss) * 1.000001f;
                nm = fmaxf(nm, swz_xor<1>(nm)); nm = fmaxf(nm, swz_xor<2>(nm)); nm = fmaxf(nm, swz_xor<4>(nm)); nm = fmaxf(nm, swz_xor<8>(nm)); nm = fmaxf(nm, swz_xor<16>(nm));
                { auto rr = __builtin_amdgcn_permlane32_swap(__float_as_uint(nm), __float_as_uint(nm), false, false); nm = fmaxf(__uint_as_float(rr[0]), __uint_as_float(rr[1])); }
                if (lane == 0) ((float*)(ws + WS_TKN))[it] = nm; }
            }
            __syncthreads();
            pg8::Shape g{QLORA, NPROJ, QLORA};
            SchedMlaUp S{G, bx, (unsigned)(WS_PROJ + C_CQ * 2), (unsigned)(WS_PROJ + C_CKV * 2), (unsigned)(WS_WQB + (size_t)l * NQM * QLORA * 2), (unsigned)(WS_WKVB + (size_t)l * NKVM * QLORA * 2)};
            EpiMlaUp E{QM, KVM, ssq, cosT, sinT};
            pg8::gemm_phase(ldsL, (const char*)ws, wave0, g, S, E);
        }
        SEAM(P + 1);
        for (int rep_ = 0; rep_ < NREP(2); ++rep_) if (IN(P + 2) && EN(2)) {
            PHASE_PTRS();
            for (int it = vcu; it < 256; it += G) { const int bh = it >> 3, s = it & 7, b = bh >> 3, h = bh & 7;
                if (ATT_MODES & 1) { att::Args a{PROJ + C_MOBA, NPROJ, nullptr, PROJ + C_MOBA + 1024, NPROJ, nullptr, PROJ + C_MOBA + 2048, NPROJ, OATT, nullptr, kmh, kml, (const float*)(ws + WS_TKN)};
                  for (int ps = 0; ps < 2; ++ps) att::attn_unit<att::MOBA>(a, b, h, ps ? 15 - s : s, ldsL, wave0); }
                if (ATT_MODES & 2) { att::Args a{PROJ + C_FOX, NPROJ, nullptr, PROJ + C_FOX + 1024, NPROJ, nullptr, PROJ + C_FOX + 2048, NPROJ, OATT + 1024, cb, nullptr, nullptr, (const float*)(ws + WS_TKN) + 2048};
                  for (int ps = 0; ps < 2; ++ps) att::attn_unit<att::FOX>(a, b, h, ps ? 15 - s : s, ldsL, wave0); }
                if (ATT_MODES & 4) { att::Args a{QM, NQM, QM + 1024, KVM, NKVM, kpe, KVM + 1024, NKVM, OATT + 2048, nullptr, nullptr, nullptr, nullptr};
                  for (int ps = 0; ps < 2; ++ps) att::attn_unit<att::MLA>(a, b, h, ps ? 15 - s : s, ldsL, wave0); }
            }
        }
        SEAM(P + 2);
        for (int rep_ = 0; rep_ < NREP(3); ++rep_) if (IN(P + 3) && EN(3)) {
            PHASE_PTRS();
            pg8::Shape g{1024, NOATT, 1024};
            SchedMerge S{G, bx, (unsigned)WS_OATT, (unsigned)(WS_WBR + (size_t)l * 3 * DM * 1024 * 2)};
            EpiGateMerge E{PROJ, MERGED};
            pg8::gemm_phase(ldsL, (const char*)ws, wave0, g, S, E);
        }
        SEAM(P + 3);
        for (int rep_ = 0; rep_ < NREP(4); ++rep_) if (IN(P + 4) && EN(4)) {
            PHASE_PTRS();
            pg8::Shape g{DM, DM, DM};
            SchedPlain S{64, 8, G, bx, (unsigned)WS_MERGED, (unsigned)(WS_WO + (size_t)l * DM * DM * 2), 256u * DM * 2, 256u * DM * 2};
            EpiResidual E{XB, Y};
            pg8::gemm_phase(ldsL, (const char*)ws, wave0, g, S, E);
        }
        SEAM(P + 4);
        if (IN(P + 5) && EN(5)) {
            PHASE_PTRS(); OPAQUE_IDS();
            const float* g1 = args.ln1_g + l * DM; const float* b1 = args.ln1_b + l * DM;
            if (l == 0) {
                for (int m = gw; m < MTOK; m += NGW) { f32x4 v[8]; const u32x4* yr = (const u32x4*)(Y + (size_t)m * DM);
#pragma unroll
                    for (int jj = 0; jj < 4; ++jj) unpack8(yr[lane + 64 * jj], v[2 * jj], v[2 * jj + 1]);
                    ln_row(v, g1, b1, lane); u32x4* o16 = (u32x4*)(X1 + (size_t)m * DM);
#pragma unroll
                    for (int jj = 0; jj < 4; ++jj) o16[lane + 64 * jj] = pack8(v[2 * jj], v[2 * jj + 1]); }
            } else {
                LAS float* wrT = (LAS float*)ldsL; LAS int* selE = (LAS int*)(ldsL + 65536); LAS float* selG = (LAS float*)(ldsL + 65536 + 1024); LAS int* dstR = (LAS int*)(ldsL + 65536 + 2048);
                for (int u = tid; u < DM * NEXP; u += NWAVES * 64) { const int d = u >> 3, e = u & 7; wrT[e * DM + d] = args.moe_router[u]; }
                __syncthreads();
                for (int c0 = vcu * 64; c0 < MTOK; c0 += G * 64) {
                    for (int i = 0; i < 8; ++i) { const int tl = wave * 8 + i, m = c0 + tl; f32x4 v[8]; const u32x4* yr = (const u32x4*)(Y + (size_t)m * DM);
#pragma unroll
                        for (int jj = 0; jj < 4; ++jj) unpack8(yr[lane + 64 * jj], v[2 * jj], v[2 * jj + 1]);
                        ln_row(v, g1, b1, lane); u32x4* o16 = (u32x4*)(X1 + (size_t)m * DM);
#pragma unroll
                        for (int jj = 0; jj < 4; ++jj) o16[lane + 64 * jj] = pack8(v[2 * jj], v[2 * jj + 1]);
                        float lg[8];
#pragma unroll
                        for (int e = 0; e < 8; ++e) { float s = 0.f;
#pragma unroll
                            for (int j = 0; j < 8; ++j) { const f32x4 w = *(const LAS f32x4*)(wrT + e * DM + 4 * LNC(j)); s += (v[j][0] * w[0] + v[j][1] * w[1]) + (v[j][2] * w[2] + v[j][3] * w[3]); }
                            lg[e] = wave_sum(s); }
                        int e0 = 0; float v0 = lg[0];
#pragma unroll
                        for (int e = 1; e < 8; ++e) if (lg[e] > v0) { v0 = lg[e]; e0 = e; }
                        int e1 = -1; float v1 = -__builtin_inff();
#pragma unroll
                        for (int e = 0; e < 8; ++e) if (e != e0 && lg[e] > v1) { v1 = lg[e]; e1 = e; }
                        const float g0 = 1.0f / (1.0f + expf(v1 - v0));
                        if (lane == 0) { selE[tl * 2] = e0; selE[tl * 2 + 1] = e1; selG[tl * 2] = g0; selG[tl * 2 + 1] = 1.0f - g0; } }
                    __syncthreads();
                    if (wave == 0) { const int e0 = selE[lane * 2], e1 = selE[lane * 2 + 1]; int r0 = 0, r1 = 0, mycnt = 0;
                        const unsigned long long lt = (1ull << lane) - 1ull;
#pragma unroll
                        for (int e = 0; e < 8; ++e) { const unsigned long long m0 = __ballot(e0 == e), m1 = __ballot(e1 == e); const int c0e = __popcll(m0);
                            if (e0 == e) r0 = __popcll(m0 & lt); if (e1 == e) r1 = c0e + __popcll(m1 & lt); if (lane == e) mycnt = c0e + __popcll(m1); }
                        int mybase = 0; if (lane < 8) mybase = (int)atomicAdd(ctl + CW_CNT + lane, (unsigned)mycnt);
                        const int b0 = __builtin_amdgcn_ds_bpermute(e0 << 2, mybase), b1 = __builtin_amdgcn_ds_bpermute(e1 << 2, mybase); const int m = c0 + lane;
                        const int p0 = b0 + r0, p1 = b1 + r1;
                        ltok[e0 * MTOK + p0] = m; ldst[e0 * MTOK + p0] = 2 * m; lgate[e0 * MTOK + p0] = selG[lane * 2];
                        ltok[e1 * MTOK + p1] = m; ldst[e1 * MTOK + p1] = 2 * m + 1; lgate[e1 * MTOK + p1] = selG[lane * 2 + 1];
                        dstR[lane * 2] = e0 * MTOK + p0; dstR[lane * 2 + 1] = e1 * MTOK + p1; }
                    __syncthreads();
                    for (int i = 0; i < 8; ++i) { const int tl = wave * 8 + i, m = c0 + tl; const u32x4* xr = (const u32x4*)(X1 + (size_t)m * DM);
                        const int d0 = __builtin_amdgcn_readfirstlane(dstR[tl * 2]), d1 = __builtin_amdgcn_readfirstlane(dstR[tl * 2 + 1]);
                        u32x2* o0 = (u32x2*)(XGFR + (size_t)d0 * DM); u32x2* o1 = (u32x2*)(XGFR + (size_t)d1 * DM);
#pragma unroll
                        for (int jj = 0; jj < 4; ++jj) { f32x4 a0, a1; unpack8(xr[lane + 64 * jj], a0, a1); u32x2 w;
                            w.x = pk4_fp8(a0[0] * X_SCALE, a0[1] * X_SCALE, a0[2] * X_SCALE, a0[3] * X_SCALE); w.y = pk4_fp8(a1[0] * X_SCALE, a1[1] * X_SCALE, a1[2] * X_SCALE, a1[3] * X_SCALE);
                            o0[lane + 64 * jj] = w; o1[lane + 64 * jj] = w; } }
                    __syncthreads();
                }
            }
        }
        SEAM(P + 5);
        for (int rep_ = 0; rep_ < NREP(7); ++rep_) if (IN(P + 7) && EN(7)) {
            PHASE_PTRS();
            if (l == 0) {
                pg8::Shape g{DM, DM, DM};
                SchedPlain S{64, 2 * DFF / 256, G, bx, (unsigned)WS_X1, (unsigned)WS_WF13, 256u * DM * 2, 256u * DM * 2};
                EpiSwiGLU E{HID, DFF};
                pg8::gemm_phase(ldsL, (const char*)ws, wave0, g, S, E);
            } else {
                MOE_COUNTS();
                pg8::Shape g{DM / 2, DM / 2, DM / 2};
                SchedMoe S; S.nM = tb[8]; S.nN = 2 * DFFE / 256; S.G = G; S.c = bx; S.A = (unsigned)WS_XGFR; S.regA = 1; S.B = (unsigned)WS_WM13; S.tA = 256u * DM; S.tB = 256u * DM; S.eB = 2u * DFFE * DM;
                S.tbp = (unsigned long long)((unsigned)tb[1] | ((unsigned)tb[2] << 8) | ((unsigned)tb[3] << 16) | ((unsigned)tb[4] << 24)) | ((unsigned long long)((unsigned)tb[5] | ((unsigned)tb[6] << 8) | ((unsigned)tb[7] << 16) | ((unsigned)tb[8] << 24)) << 32);
                EpiSwiGLU8 E{(unsigned char*)HID, DFFE};
                pg8::gemm_phase<EpiSwiGLU8, SchedMoe, true>(ldsL, (const char*)ws, wave0, g, S, E);
            }
        }
        SEAM(P + 7);
        for (int rep_ = 0; rep_ < NREP(8); ++rep_) if (IN(P + 8) && EN(8)) {
            PHASE_PTRS();
            if (l == 0) {
                pg8::Shape g{DFF, DFF, DFF};
                SchedPlain S{64, 8, G, bx, (unsigned)WS_HID, (unsigned)WS_WF2, 256u * DFF * 2, 256u * DFF * 2};
                EpiResidual E{X1, Y};
                pg8::gemm_phase(ldsL, (const char*)ws, wave0, g, S, E);
            } else {
                MOE_COUNTS();
                pg8::Shape g{DFFE / 2, DFFE / 2, DFFE / 2};
                SchedMoe S; S.nM = tb[8]; S.nN = 8; S.G = G; S.c = bx; S.A = (unsigned)WS_HID; S.regA = 0; S.B = (unsigned)WS_WM2; S.tA = 256u * DFFE; S.tB = 256u * DFFE; S.eB = (unsigned)DM * DFFE;
                S.tbp = (unsigned long long)((unsigned)tb[1] | ((unsigned)tb[2] << 8) | ((unsigned)tb[3] << 16) | ((unsigned)tb[4] << 24)) | ((unsigned long long)((unsigned)tb[5] | ((unsigned)tb[6] << 8) | ((unsigned)tb[7] << 16) | ((unsigned)tb[8] << 24)) << 32);
                EpiMoeDown E; E.ymoe = YMOE; E.ldst = ldst; E.lgate = lgate;
                E.tbp = (unsigned long long)((unsigned)tb[0] | ((unsigned)tb[1] << 8) | ((unsigned)tb[2] << 16) | ((unsigned)tb[3] << 24)) | ((unsigned long long)((unsigned)tb[4] | ((unsigned)tb[5] << 8) | ((unsigned)tb[6] << 16) | ((unsigned)tb[7] << 24)) << 32);
                E.cntp = ctl + CW_CNT;
                pg8::gemm_phase<EpiMoeDown, SchedMoe, true>(ldsL, (const char*)ws, wave0, g, S, E);
            }
        }
        SEAM(P + 8);
        for (int rep_ = 0; rep_ < NREP(9); ++rep_) if (IN(P + 9) && EN(9)) {
            PHASE_PTRS(); OPAQUE_IDS();
            const float* g2 = args.ln2_g + l * DM; const float* b2 = args.ln2_b + l * DM;
            for (int m = gw; m < MTOK; m += NGW) { f32x4 v[8];
                if (l == 0) { const u32x4* yr = (const u32x4*)(Y + (size_t)m * DM);
#pragma unroll
                    for (int jj = 0; jj < 4; ++jj) unpack8(yr[lane + 64 * jj], v[2 * jj], v[2 * jj + 1]);
                } else { const u32x4* xr = (const u32x4*)(X1 + (size_t)m * DM); const u32x4* y0 = (const u32x4*)(YMOE + (size_t)(2 * m) * DM); const u32x4* y1 = (const u32x4*)(YMOE + (size_t)(2 * m + 1) * DM);
#pragma unroll
                    for (int jj = 0; jj < 4; ++jj) { f32x4 a0, a1, p0, p1, q0, q1; unpack8(xr[lane + 64 * jj], a0, a1); unpack8(y0[lane + 64 * jj], p0, p1); unpack8(y1[lane + 64 * jj], q0, q1);
                        v[2 * jj] = a0 * ALPHA + p0 + q0; v[2 * jj + 1] = a1 * ALPHA + p1 + q1; } }
                ln_row(v, g2, b2, lane);
                if (l == 0) { u32x4* o16 = (u32x4*)(XB + (size_t)m * DM); u32x2* o8 = (u32x2*)(ws + WS_XBF + (size_t)m * DM);
#pragma unroll
                    for (int jj = 0; jj < 4; ++jj) { o16[lane + 64 * jj] = pack8(v[2 * jj], v[2 * jj + 1]);
                        u32x2 w; w.x = pk4_fp8(v[2 * jj][0] * X_SCALE, v[2 * jj][1] * X_SCALE, v[2 * jj][2] * X_SCALE, v[2 * jj][3] * X_SCALE);
                        w.y = pk4_fp8(v[2 * jj + 1][0] * X_SCALE, v[2 * jj + 1][1] * X_SCALE, v[2 * jj + 1][2] * X_SCALE, v[2 * jj + 1][3] * X_SCALE); o8[lane + 64 * jj] = w; }
                } else { f32x4* o = (f32x4*)(args.out + (size_t)m * DM);
#pragma unroll
                    for (int j = 0; j < 8; ++j) o[LNC(j)] = v[j]; } }
        }
        if (l == 0) SEAM(P + 9);
        }

__global__ void __launch_bounds__(NWAVES * 64, 2) hyb_fwd(KArgs args) {
    extern __shared__ __attribute__((aligned(16))) unsigned char lds[];
    LAS unsigned char* ldsL = (LAS unsigned char*)lds;
    volatile LAS unsigned* MISC = (volatile LAS unsigned*)(ldsL + MISC_OFF);
    const int tid0 = threadIdx.x; const int wave0 = __builtin_amdgcn_readfirstlane(tid0 >> 6);
    unsigned char* ws = args.ws;
    unsigned* ctl = (unsigned*)(ws + WS_CTL);
    for (int u = tid0; u < (LDS_BYTES - RING_BYTES) / 4; u += NWAVES * 64) ((LAS unsigned*)(ldsL + RING_BYTES))[u] = 0u;
    __syncthreads();
    if (MK_N_LAUNCHES == 1) (void)xcd_barrier_post(ctl + CW_BAR, MISC + 8);
    const int lo = args.ph_lo, hi = args.ph_hi;
    for (int rep_ = 0; rep_ < NREP(10); ++rep_) if (IN(0) && EN(10)) {
        PHASE_PTRS(); OPAQUE_IDS();
        LAS float* scr = (LAS float*)(ldsL + wave * 16384);
        for (int l = 0; l < 2; ++l) {
            transpose_matrix<MAP_WIN>(args.w_in + (size_t)l * DM * SRC_NPROJ, nullptr, nullptr, DM, SRC_NPROJ, NWIN16, (bf16_t*)(ws + WS_WIN) + (size_t)l * NWIN16 * DM, scr, gw, NGW, lane);
            transpose_matrix_f8<MAP_WING>(args.w_in + (size_t)l * DM * SRC_NPROJ, nullptr, W13_SCALE, DM, SRC_NPROJ, 6144, ws + WS_WINF + (size_t)l * 6144 * DM, scr, gw, NGW, lane);
            transpose_matrix<MAP_WQB>(args.w_q_b + (size_t)l * QLORA * NQM, nullptr, args.g_q_a + l * QLORA, QLORA, NQM, NQM, (bf16_t*)(ws + WS_WQB) + (size_t)l * NQM * QLORA, scr, gw, NGW, lane);
            transpose_matrix<MAP_WKVB>(args.w_kv_b + (size_t)l * QLORA * NKVM, nullptr, args.g_kv_a + l * QLORA, QLORA, NKVM, NKVM, (bf16_t*)(ws + WS_WKVB) + (size_t)l * NKVM * QLORA, scr, gw, NGW, lane);
            for (int br = 0; br < 3; ++br)
                transpose_matrix<MAP_ID>(args.w_br[br] + (size_t)l * 1024 * DM, nullptr, nullptr, 1024, DM, DM, (bf16_t*)(ws + WS_WBR) + ((size_t)l * 3 + br) * DM * 1024, scr, gw, NGW, lane);
            transpose_matrix<MAP_ID>(args.w_o + (size_t)l * DM * DM, nullptr, nullptr, DM, DM, DM, (bf16_t*)(ws + WS_WO) + (size_t)l * DM * DM, scr, gw, NGW, lane);
        }
        transpose_matrix<MAP_GLU>(args.ffn_w1, args.ffn_w3, nullptr, DM, DFF, 2 * DFF, (bf16_t*)(ws + WS_WF13), scr, gw, NGW, lane);
        transpose_matrix<MAP_ID>(args.ffn_w2, nullptr, nullptr, DFF, DM, DM, (bf16_t*)(ws + WS_WF2), scr, gw, NGW, lane);
        for (int e = 0; e < NEXP; ++e) {
            transpose_matrix_f8<MAP_GLU>(args.moe_w1 + (size_t)e * DM * DFFE, args.moe_w3 + (size_t)e * DM * DFFE, W13_SCALE, DM, DFFE, 2 * DFFE, ws + WS_WM13 + (size_t)e * 2 * DFFE * DM, scr, gw, NGW, lane);
            transpose_matrix_f8<MAP_ID>(args.moe_w2 + (size_t)e * DFFE * DM, nullptr, W2_SCALE, DFFE, DM, DM, ws + WS_WM2 + (size_t)e * DM * DFFE, scr, gw, NGW, lane);
        }
        for (int m = gw; m < MTOK; m += NGW) { const f32x4* xr = (const f32x4*)(args.x + (size_t)m * DM); u32x2* o8 = (u32x2*)(XB + (size_t)m * DM);
#pragma unroll
            for (int j = 0; j < 8; ++j) { const f32x4 v = xr[lane + 64 * j]; u32x2 w; w.x = cvt_pk_bf16(v[0], v[1]); w.y = cvt_pk_bf16(v[2], v[3]); o8[lane + 64 * j] = w;
                ((unsigned*)(ws + WS_XBF + (size_t)m * DM))[lane + 64 * j] = pk4_fp8(v[0] * X_SCALE, v[1] * X_SCALE, v[2] * X_SCALE, v[3] * X_SCALE); } }
        for (int idx = bx * (NWAVES * 64) + tid; idx < MTOK * 32; idx += G * NWAVES * 64) { const int m = idx >> 5, i = idx & 31;
            const double ang = (double)args.pos[m] * ROPE_INV[i]; const double t = ang * 0.15915494309189535; const double fr = t - floor(t);
            const double x4 = fr * 4.0; const int oct = (int)x4; const double r = (x4 - (double)oct) * 1.5707963267948966;
            const double rr = r - 0.7853981633974483, r2 = rr * rr;
            double sn = rr * (1.0 + r2 * (-1.0 / 6 + r2 * (1.0 / 120 + r2 * (-1.0 / 5040 + r2 * (1.0 / 362880 + r2 * (-1.0 / 39916800 + r2 * (1.0 / 6227020800.0)))))));
            double cs = 1.0 + r2 * (-0.5 + r2 * (1.0 / 24 + r2 * (-1.0 / 720 + r2 * (1.0 / 40320 + r2 * (-1.0 / 3628800 + r2 * (1.0 / 479001600.0 + r2 * (-1.0 / 87178291200.0)))))));
            const double h = 0.7071067811865476; const double s1 = h * (sn + cs), c1 = h * (cs - sn);
            double so, co; if (oct == 0) { so = s1; co = c1; } else if (oct == 1) { so = c1; co = -s1; } else if (oct == 2) { so = -s1; co = -c1; } else { so = -c1; co = s1; }
            cosT[idx] = (float)co; sinT[idx] = (float)so; }
        if (bx == 0) { for (int u = tid; u < DM / 2; u += NWAVES * 64) { ((unsigned*)(XB + (size_t)MTOK * DM))[u] = 0u; ((unsigned*)(X1 + (size_t)MTOK * DM))[u] = 0u; } }
    }
    SEAM(0);

    const LArgs la{args.b_forget, args.ln1_g, args.ln1_b, args.ln2_g, args.ln2_b, args.moe_router, args.out, args.ws};
    layer_fn<0>(la, ldsL, MISC, wave0, lo, hi);
    layer_fn<1>(la, ldsL, MISC, wave0, lo, hi);
#undef IN
#undef SEAM
}

extern "C" void kernel_launch(void* const* d_in, const int* in_sizes, int n_in, void* d_out, int out_size, void* d_ws, size_t ws_size, hipStream_t stream) {
    static int grid = 0;
    if (grid == 0) {
        if (n_in != 23 || ws_size < WS_END) { fprintf(stderr, "kernel_launch: need 23 inputs and >= %zu bytes of workspace; got %d, %zu\n", (size_t)WS_END, n_in, ws_size); grid = -1; return; }
        int dev = 0, cus = 0;
        if (hipGetDevice(&dev) != hipSuccess || hipDeviceGetAttribute(&cus, hipDeviceAttributeMultiprocessorCount, dev) != hipSuccess) { grid = -1; return; }
        if (hipFuncSetAttribute((const void*)hyb_fwd, hipFuncAttributeMaxDynamicSharedMemorySize, LDS_BYTES) != hipSuccess) { fprintf(stderr, "kernel_launch: hipFuncSetAttribute failed\n"); grid = -1; return; }
        int per_cu = 0;
        if (hipOccupancyMaxActiveBlocksPerMultiprocessor(&per_cu, (const void*)hyb_fwd, NWAVES * 64, LDS_BYTES) != hipSuccess || per_cu < 1) { fprintf(stderr, "kernel_launch: occupancy query says %d\n", per_cu); }
        (void)hipGetLastError();
        grid = cus;
    }
    if (grid < 0) return;
    (void)hipMemsetAsync((char*)d_ws + WS_CTL, 0, CTL_ZERO_BYTES, stream);
    KArgs a{};
    a.x = (const float*)d_in[0]; a.pos = (const int*)d_in[1]; a.w_in = (const float*)d_in[2]; a.b_forget = (const float*)d_in[3]; a.g_q_a = (const float*)d_in[4]; a.g_kv_a = (const float*)d_in[5];
    a.w_q_b = (const float*)d_in[6]; a.w_kv_b = (const float*)d_in[7]; a.w_br[0] = (const float*)d_in[8]; a.w_br[1] = (const float*)d_in[9]; a.w_br[2] = (const float*)d_in[10]; a.w_o = (const float*)d_in[11];
    a.ln1_g = (const float*)d_in[12]; a.ln1_b = (const float*)d_in[13]; a.ln2_g = (const float*)d_in[14]; a.ln2_b = (const float*)d_in[15];
    a.ffn_w1 = (const float*)d_in[16]; a.ffn_w3 = (const float*)d_in[17]; a.ffn_w2 = (const float*)d_in[18]; a.moe_router = (const float*)d_in[19]; a.moe_w1 = (const float*)d_in[20]; a.moe_w3 = (const float*)d_in[21]; a.moe_w2 = (const float*)d_in[22];
    a.out = (float*)d_out; a.ws = (unsigned char*)d_ws;
#if MK_N_LAUNCHES == 1
    a.ph_lo = 0; a.ph_hi = N_PHASES;
    hipLaunchKernelGGL(hyb_fwd, dim3(grid), dim3(NWAVES * 64), LDS_BYTES, stream, a);
#else
    for (int p = 0; p < N_PHASES; ++p) { if (p == 7) continue; a.ph_lo = p; a.ph_hi = p + 1; hipLaunchKernelGGL(hyb_fwd, dim3(grid), dim3(NWAVES * 64), LDS_BYTES, stream, a); }
#endif
}
```
